# Optimizing an MI355X kernel written in HIP

```python
import math
import jax, jax.numpy as jnp
from jax import lax
import numpy as np

D_MODEL = 1024
BATCH = 16
SEQ = 256
DEPTH = 1
DEC_BATCH = 2
DEC_SEQ = 4096
PAST_LEN = 256

GRID_W = 64
S5_WIDTH = 512
S5_GROUP = 16
S5_GROUPS = S5_WIDTH // S5_GROUP
S5_STATE = 64
FFT_WIDTH = D_MODEL - S5_WIDTH
FFT_GROUPS = 4
FFT_GROUP = FFT_WIDTH // FFT_GROUPS
N_BRANCH = 2
IN_WIDTH = S5_WIDTH + FFT_WIDTH + N_BRANCH * D_MODEL
_FF_RAW = -(-8 * D_MODEL // 3)
D_FF = -(-_FF_RAW // 256) * 256
N_MOD = 6
EPS = 1e-6

kernel_name = "hybrid_s5_fnet_flow_step"


def rmsnorm(x, g):
    x32 = x.astype(jnp.float32)
    y = x32 * lax.rsqrt(jnp.mean(x32 * x32, axis=-1, keepdims=True) + EPS)
    return (y * g.astype(jnp.float32)).astype(x.dtype)


def adaln(cvec, w_ada, b_ada):
    m = jax.nn.silu(cvec) @ w_ada + b_ada
    return m.reshape(cvec.shape[0], N_MOD, D_MODEL)


def _cmul(ar, ai, br, bi):
    return ar * br - ai * bi, ar * bi + ai * br


def _scan_op(e1, e2):
    a1r, a1i, b1r, b1i = e1
    a2r, a2i, b2r, b2i = e2
    ar, ai = _cmul(a1r, a1i, a2r, a2i)
    br, bi = _cmul(a2r, a2i, b1r, b1i)
    return ar, ai, br + b2r, bi + b2i


def s5_discretise(lam_re, lam_im, log_step, b_re, b_im):
    step = jnp.exp(log_step)[:, None]
    mag = jnp.exp(lam_re * step)
    ab_re = mag * jnp.cos(lam_im * step)
    ab_im = mag * jnp.sin(lam_im * step)
    nr = ab_re - 1.0
    ni = ab_im
    den = lam_re * lam_re + lam_im * lam_im
    fr = (nr * lam_re + ni * lam_im) / den
    fi = (ni * lam_re - nr * lam_im) / den
    bb_re = fr[..., None] * b_re - fi[..., None] * b_im
    bb_im = fr[..., None] * b_im + fi[..., None] * b_re
    return ab_re, ab_im, bb_re, bb_im


def s5_direction(u, lam_re, lam_im, log_step, b_re, b_im, c_re, c_im, h0_re, h0_im, reverse):
    ab_re, ab_im, bb_re, bb_im = s5_discretise(lam_re, lam_im, log_step, b_re, b_im)
    bu_re = jnp.einsum("nlgh,gph->nlgp", u, bb_re)
    bu_im = jnp.einsum("nlgh,gph->nlgp", u, bb_im)
    a_re = jnp.broadcast_to(ab_re, bu_re.shape)
    a_im = jnp.broadcast_to(ab_im, bu_im.shape)
    acum_re, acum_im, s_re, s_im = lax.associative_scan(
        _scan_op, (a_re, a_im, bu_re, bu_im), reverse=reverse, axis=1)
    hr, hi = _cmul(acum_re, acum_im, h0_re[:, None], h0_im[:, None])
    s_re = s_re + hr
    s_im = s_im + hi
    y = jnp.einsum("nlgp,ghp->nlgh", s_re, c_re) - jnp.einsum("nlgp,ghp->nlgh", s_im, c_im)
    end = 0 if reverse else -1
    return y, s_re[:, end], s_im[:, end]


def s5_branch(u, h0, p):
    n, l, _ = u.shape
    f32 = jnp.float32
    v = u.astype(f32).reshape(n, l, S5_GROUPS, S5_GROUP)
    h0 = h0.astype(f32)
    y = p["s5_d"].astype(f32).reshape(S5_GROUPS, S5_GROUP) * v
    finals = []
    for d in range(2):
        y_d, f_re, f_im = s5_direction(
            v,
            p["s5_lambda_re"][d].astype(f32), p["s5_lambda_im"][d].astype(f32),
            p["s5_log_step"][d].astype(f32),
            p["s5_b_re"][d].astype(f32), p["s5_b_im"][d].astype(f32),
            p["s5_c_re"][d].astype(f32), p["s5_c_im"][d].astype(f32),
            h0[:, d, 0], h0[:, d, 1], reverse=(d == 1))
        y = y + y_d
        finals.append(jnp.stack([f_re, f_im], axis=1))
    y = y.reshape(n, l, S5_WIDTH).astype(u.dtype)
    z = jax.nn.gelu(y)
    z = z * jax.nn.sigmoid(z @ p["w_glu"] + p["b_glu"])
    return z, jnp.stack(finals, axis=1)


def fourier_branch(u):
    n, l, _ = u.shape
    v = u.astype(jnp.float32).reshape(n, l, FFT_GROUPS, FFT_GROUP)
    f = jnp.fft.fft2(v, axes=(1, 3), norm="ortho").real
    return f.reshape(n, l, FFT_WIDTH).astype(u.dtype)


def layer(x, mod, h0, p):
    shift1, scale1, gate1, shift2, scale2, gate2 = [mod[:, k][:, None] for k in range(N_MOD)]
    h = rmsnorm(x, p["norm1_g"]) * (1.0 + scale1) + shift1
    z = h @ p["w_in"]
    o = 0
    u_s5 = z[..., o:o + S5_WIDTH]; o += S5_WIDTH
    u_f = z[..., o:o + FFT_WIDTH]; o += FFT_WIDTH
    g_s5 = z[..., o:o + D_MODEL]; o += D_MODEL
    g_f = z[..., o:o + D_MODEL]
    y_s5, finals = s5_branch(u_s5, h0, p)
    y_f = fourier_branch(u_f)
    m = (jax.nn.sigmoid(g_s5) * (y_s5 @ p["w_proj_s5"])
         + jax.nn.sigmoid(g_f) * (y_f @ p["w_proj_fft"]))
    x = x + gate1 * (m @ p["w_out"])
    h2 = rmsnorm(x, p["norm2_g"]) * (1.0 + scale2) + shift2
    ff = (jax.nn.silu(h2 @ p["w_ffn_gate"]) * (h2 @ p["w_ffn_up"])) @ p["w_ffn_down"]
    x = x + gate2 * ff
    return x, finals


def setup_inputs(seed: int = 0) -> dict:
    key = jax.random.key(seed)
    ks = iter(jax.random.split(key, 40))
    f32 = jnp.float32
    D, G, P, H = D_MODEL, S5_GROUPS, S5_STATE, S5_GROUP

    def nrm(shape, scale):
        return jax.random.normal(next(ks), shape, f32) * scale

    lam_im_base = jnp.pi * jnp.arange(P, dtype=f32)
    return {
        "x_prompt": nrm((BATCH, SEQ, D), 1.0),
        "x_sample": nrm((DEC_BATCH, DEC_SEQ, D), 1.0),
        "state_s5": nrm((DEC_BATCH, DEPTH, 2, 2, G, P), 0.5),
        "c": nrm((DEC_BATCH, D), 1.0),
        "c_ctx": nrm((D,), 1.0),
        "norm1_g": 1.0 + nrm((DEPTH, D), 0.02),
        "norm2_g": 1.0 + nrm((DEPTH, D), 0.02),
        "w_ada": nrm((DEPTH, D, N_MOD * D), 0.5 * D ** -0.5),
        "b_ada": nrm((DEPTH, N_MOD * D), 0.01),
        "w_in": nrm((DEPTH, D, IN_WIDTH), D ** -0.5),
        "s5_lambda_re": -0.5 + nrm((DEPTH, 2, G, P), 0.01),
        "s5_lambda_im": lam_im_base + nrm((DEPTH, 2, G, P), 0.01),
        "s5_log_step": jax.random.uniform(next(ks), (DEPTH, 2, G), f32,
                                          math.log(1e-3), math.log(1e-1)),
        "s5_b_re": nrm((DEPTH, 2, G, P, H), (2 * H) ** -0.5),
        "s5_b_im": nrm((DEPTH, 2, G, P, H), (2 * H) ** -0.5),
        "s5_c_re": nrm((DEPTH, 2, G, H, P), P ** -0.5),
        "s5_c_im": nrm((DEPTH, 2, G, H, P), P ** -0.5),
        "s5_d": nrm((DEPTH, S5_WIDTH), 1.0),
        "w_glu": nrm((DEPTH, S5_WIDTH, S5_WIDTH), S5_WIDTH ** -0.5),
        "b_glu": nrm((DEPTH, S5_WIDTH), 0.01),
        "w_proj_s5": nrm((DEPTH, S5_WIDTH, D), S5_WIDTH ** -0.5),
        "w_proj_fft": nrm((DEPTH, FFT_WIDTH, D), FFT_WIDTH ** -0.5),
        "w_out": nrm((DEPTH, D, D), D ** -0.5),
        "w_ffn_gate": nrm((DEPTH, D, D_FF), D ** -0.5),
        "w_ffn_up": nrm((DEPTH, D, D_FF), D ** -0.5),
        "w_ffn_down": nrm((DEPTH, D_FF, D), D_FF ** -0.5),
        "final_norm_g": 1.0 + nrm((D,), 0.02),
    }


def reference(x_prompt, x_sample, state_s5, c, c_ctx, norm1_g, norm2_g, w_ada, b_ada, w_in,
              s5_lambda_re, s5_lambda_im, s5_log_step, s5_b_re, s5_b_im, s5_c_re, s5_c_im,
              s5_d, w_glu, b_glu, w_proj_s5, w_proj_fft, w_out, w_ffn_gate, w_ffn_up,
              w_ffn_down, final_norm_g):
    xp = x_prompt
    xs = x_sample
    n_ctx = x_prompt.shape[0]
    zero_state = jnp.zeros((n_ctx, 2, 2, S5_GROUPS, S5_STATE), jnp.float32)
    new_states = []
    for i in range(DEPTH):
        p = {
            "norm1_g": norm1_g[i], "norm2_g": norm2_g[i], "w_in": w_in[i],
            "s5_lambda_re": s5_lambda_re[i], "s5_lambda_im": s5_lambda_im[i],
            "s5_log_step": s5_log_step[i], "s5_b_re": s5_b_re[i], "s5_b_im": s5_b_im[i],
            "s5_c_re": s5_c_re[i], "s5_c_im": s5_c_im[i], "s5_d": s5_d[i],
            "w_glu": w_glu[i], "b_glu": b_glu[i], "w_proj_s5": w_proj_s5[i],
            "w_proj_fft": w_proj_fft[i], "w_out": w_out[i], "w_ffn_gate": w_ffn_gate[i],
            "w_ffn_up": w_ffn_up[i], "w_ffn_down": w_ffn_down[i],
        }
        mod_ctx = adaln(c_ctx[None], w_ada[i], b_ada[i])
        mod_lat = adaln(c, w_ada[i], b_ada[i])
        xp, finals_ctx = layer(xp, mod_ctx, zero_state, p)
        new_states.append(finals_ctx)
        xs, _ = layer(xs, mod_lat, state_s5[:, i], p)
    y_prompt = rmsnorm(xp, final_norm_g)
    y_sample = rmsnorm(xs, final_norm_g)
    new_state_s5 = jnp.stack(new_states, axis=1)
    return (y_prompt, y_sample, new_state_s5)
```

```cpp
#include <hip/hip_runtime.h>
#include <hip/hip_cooperative_groups.h>
#include <cstdio>
#include <cstdint>
namespace cg = cooperative_groups;

#define LAS __attribute__((address_space(3)))
typedef unsigned short bf16_t;
typedef short bf16x8 __attribute__((ext_vector_type(8)));
typedef float f32x4 __attribute__((ext_vector_type(4)));
typedef float f32x2 __attribute__((ext_vector_type(2)));
typedef unsigned u32x4 __attribute__((ext_vector_type(4)));
typedef unsigned u32x2 __attribute__((ext_vector_type(2)));

#ifndef DBG_STOP
#define DBG_STOP 0
#endif
constexpr int NT = 12288, NTP = 4096, DM = 1024, NCH = 768, DFF = 2816;
constexpr float EPS = 1e-6f;

constexpr size_t AL(size_t x) { return (x + 255) & ~(size_t)255; }
constexpr size_t WS_CTL = 0;
constexpr size_t WS_MOD = 4096;
constexpr size_t WS_SVGU = WS_MOD + AL(3 * 6144 * 4);
constexpr size_t WS_MODP = AL(WS_SVGU + 3 * 5632 * 4);
constexpr size_t WS_SSQ2 = AL(WS_MODP + 32 * 3 * 6144 * 4);
constexpr size_t WS_SSQ3 = AL(WS_SSQ2 + (size_t)NT * 16 * 4);
constexpr size_t WS_W1T = AL(WS_SSQ3 + (size_t)NT * 16 * 4);
constexpr size_t WS_WFT = WS_W1T + 2560 * 1024 * 2;
constexpr size_t WS_WGLU = WS_WFT + 1024 * 1024 * 2;
constexpr size_t WS_WPS = WS_WGLU + 512 * 512 * 2;
constexpr size_t WS_WPF = WS_WPS + 1024 * 512 * 2;
constexpr size_t WS_WO = WS_WPF + 1024 * 512 * 2;
constexpr size_t WS_WGU = WS_WO + 1024 * 1024 * 2;
constexpr size_t WS_WD = WS_WGU + (size_t)5632 * 1024 * 2;
constexpr size_t WS_R1 = AL(WS_WD + (size_t)1024 * 2816 * 2);
constexpr size_t WS_R3 = WS_R1 + (size_t)NT * 2048 * 2;
constexpr size_t WS_R4 = WS_R3 + (size_t)NT * 1024 * 2;
constexpr size_t WS_XP = WS_R4 + (size_t)16777216;
constexpr size_t WS_R5 = WS_R4 + (size_t)NT * 1024 * 2;
constexpr size_t WS_YS = WS_R5 + (size_t)NT * 512 * 2;
constexpr size_t WS_YF = WS_YS + (size_t)NT * 512 * 2;
constexpr size_t WS_R2 = WS_YF + (size_t)NT * 512 * 2;
constexpr size_t WS_END = WS_R2 + (size_t)NT * 1024 * 2;

__device__ __forceinline__ unsigned cvt_pk_bf16(float lo, float hi) { unsigned r; asm volatile("v_cvt_pk_bf16_f32 %0, %1, %2" : "=v"(r) : "v"(lo), "v"(hi)); return r; }
__device__ __forceinline__ float bf2f(unsigned short b) { return __uint_as_float(((unsigned)b) << 16); }
__device__ __forceinline__ float bflo(unsigned w) { return __uint_as_float(w << 16); }
__device__ __forceinline__ float bfhi(unsigned w) { return __uint_as_float(w & 0xffff0000u); }
__device__ __forceinline__ float sigm(float x) { return __builtin_amdgcn_rcpf(1.0f + __expf(-x)); }
__device__ __forceinline__ float gelu_tanh(float x) { const float u = 0.7978845608028654f * (x + 0.044715f * x * x * x); return x * sigm(2.0f * u); }
__device__ __forceinline__ float wave_sum(float v) {
#pragma unroll
    for (int o = 1; o < 64; o <<= 1) v += __shfl_xor(v, o);
    return v;
}
__device__ __forceinline__ void st16(void* p, u32x4 v) { asm volatile("global_store_dwordx4 %0, %1, off sc1\n\ts_nop 1" :: "v"(p), "v"(v) : "memory"); }
__device__ __forceinline__ void st16f(void* p, f32x4 v) { asm volatile("global_store_dwordx4 %0, %1, off sc1\n\ts_nop 1" :: "v"(p), "v"(v) : "memory"); }
__device__ __forceinline__ void st4f(float* p, float v) { asm volatile("global_store_dword %0, %1, off sc1\n\ts_nop 1" :: "v"(p), "v"(v) : "memory"); }
__device__ __forceinline__ void st2(bf16_t* p, unsigned v) { asm volatile("global_store_short %0, %1, off sc1\n\ts_nop 1" :: "v"(p), "v"(v) : "memory"); }
__device__ __forceinline__ u32x4 pack8(f32x4 a, f32x4 b) { u32x4 w; w.x = cvt_pk_bf16(a[0], a[1]); w.y = cvt_pk_bf16(a[2], a[3]); w.z = cvt_pk_bf16(b[0], b[1]); w.w = cvt_pk_bf16(b[2], b[3]); return w; }
__device__ __forceinline__ void unpack8(u32x4 w, f32x4& a, f32x4& b) { a = (f32x4){bflo(w.x), bfhi(w.x), bflo(w.y), bfhi(w.y)}; b = (f32x4){bflo(w.z), bfhi(w.z), bflo(w.w), bfhi(w.w)}; }
__device__ __forceinline__ void sincos_d(double th, double& s, double& c) {
    const double k = rint(th * 0.63661977236758134308);
    const double r = fma(-k, 6.123233995736766e-17, fma(-k, 1.5707963267948966, th));
    const double x2 = r * r;
    double sp = -7.6471637318198165e-13; sp = sp * x2 + 1.6059043836821613e-10; sp = sp * x2 - 2.5052108385441719e-08; sp = sp * x2 + 2.7557319223985891e-06;
    sp = sp * x2 - 1.9841269841269841e-04; sp = sp * x2 + 8.3333333333333333e-03; sp = sp * x2 - 1.6666666666666667e-01; sp = r + r * x2 * sp;
    double cp = 4.7794773323873853e-14; cp = cp * x2 - 1.1470745597729725e-11; cp = cp * x2 + 2.0876756987868099e-09; cp = cp * x2 - 2.7557319223985891e-07;
    cp = cp * x2 + 2.4801587301587302e-05; cp = cp * x2 - 1.3888888888888889e-03; cp = cp * x2 + 4.1666666666666667e-02; cp = cp * x2 - 0.5; cp = 1.0 + x2 * cp;
    const int q = ((int)k) & 3;
    s = (q == 0) ? sp : (q == 1) ? cp : (q == 2) ? -sp : -cp;
    c = (q == 0) ? cp : (q == 1) ? -sp : (q == 2) ? -cp : sp;
}
__device__ __forceinline__ void sincos_frac(int j, int N, float& s, float& c) { double ds, dc; sincos_d(6.283185307179586476925 * (double)(j & (N - 1)) / (double)N, ds, dc); s = (float)ds; c = (float)dc; }

constexpr int HTB = 128 * 64 * 2;
__device__ __forceinline__ int lds_byte(int r, int c) { const int st = (r >> 4) * 2 + (c >> 5), rr = r & 15, cc = c & 31, ob = rr * 64 + cc * 2; return st * 1024 + (ob ^ (((ob >> 9) & 1) << 5)); }
__device__ __forceinline__ void stage_rc(int b, int& R, int& C) { const int st = b / 1024, sb = b % 1024, swz = sb ^ (((sb >> 9) & 1) << 5); R = (st >> 1) * 16 + swz / 64; C = (st & 1) * 32 + (swz % 64) / 2; }
__device__ __forceinline__ int perm32(int rho) { const int n = rho >> 4, i = rho & 15; return 8 * (i >> 2) + 4 * n + (i & 3); }
struct Unit { const char* A; const char* B; int pm, pn; };
__device__ __forceinline__ void tile_of(int j, int nM, int nN, int& pm, int& pn) {
    const int nwg = nM * nN; int wgid = j;
    { const int q = nwg / 8, r = nwg % 8, xcd = wgid % 8, off = wgid / 8; wgid = (xcd < r ? xcd * (q + 1) : r * (q + 1) + (xcd - r) * q) + off; }
    const int nig = 8 * nN, gid = wgid / nig, fm = gid * 8, gsz = (nM - fm) < 8 ? (nM - fm) : 8;
    pm = fm + ((wgid % nig) % gsz); pn = (wgid % nig) / gsz;
}
template <class G>
__device__ __forceinline__ void gemm_phase(LAS unsigned char* lds, const G& g, const int L0, const int count) {
    constexpr int K = G::K, nt = K / 64;
    static_assert(nt % 2 == 0 && nt >= 2, "K");
    const int tid = threadIdx.x, wid = __builtin_amdgcn_readfirstlane(tid >> 6), lane = tid & 63, wr = wid >> 2, wc = wid & 3, fr = lane & 15, fq = lane >> 4;
    const int Gn = gridDim.x;
    int j = ((int)blockIdx.x - L0) % Gn; if (j < 0) j += Gn;
    if (j >= count) return;
    unsigned voffA[2], voffB[2];
#pragma unroll
    for (int i = 0; i < 2; ++i) { int R, C; stage_rc(tid * 16 + i * 8192, R, C); const int Rb = (R & ~31) + perm32(R & 31);
        voffA[i] = g.offA(R) + (unsigned)C * 2u; voffB[i] = g.offB(Rb) + (unsigned)C * 2u; }
    const size_t kstep = 128, hsA = G::HSA, hsB = G::HSB;
    const unsigned ldsw = (unsigned)wid * 1024u;
    const int aoff = lds_byte(wr * 64 + fr, fq * 8), boff = lds_byte(wc * 32 + fr, fq * 8);
#define PG8_SA(b, h) (((b) * 2 + (h)) * HTB)
#define PG8_SB(b, h) ((4 + (b) * 2 + (h)) * HTB)
#define PG8_STAGE(bufoff, gbase, voff) do { _Pragma("unroll") for (int _i = 0; _i < 2; ++_i) \
        __builtin_amdgcn_global_load_lds((const unsigned*)((const char*)(gbase) + (voff)[_i]), (LAS unsigned*)(lds + (bufoff) + ldsw + _i * 8192), 16, 0, 0); } while (0)
#define PG8_LDA(dst, b, h) do { _Pragma("unroll") for (int m = 0; m < 4; ++m) _Pragma("unroll") for (int k = 0; k < 2; ++k) dst[m][k] = *(const LAS bf16x8*)(lds + PG8_SA(b, h) + aoff + m * 2048 + k * 1024); } while (0)
#define PG8_LDB(dst, b, h) do { _Pragma("unroll") for (int n = 0; n < 2; ++n) _Pragma("unroll") for (int k = 0; k < 2; ++k) dst[n][k] = *(const LAS bf16x8*)(lds + PG8_SB(b, h) + boff + n * 2048 + k * 1024); } while (0)
#define PG8_MMA(ai, bj, At, Bt) do { __builtin_amdgcn_s_setprio(1); _Pragma("unroll") for (int m = 0; m < 4; ++m) _Pragma("unroll") for (int n = 0; n < 2; ++n) _Pragma("unroll") for (int k = 0; k < 2; ++k) \
        acc[ai][bj][m][n] = __builtin_amdgcn_mfma_f32_16x16x32_bf16(Bt[n][k], At[m][k], acc[ai][bj][m][n], 0, 0, 0); __builtin_amdgcn_s_setprio(0); } while (0)
#ifdef SAFE_ENGINE
#define PG8_WAIT_V(n) asm volatile("s_waitcnt vmcnt(0)" ::: "memory")
#else
#define PG8_WAIT_V(n) asm volatile("s_waitcnt vmcnt(" #n ")" ::: "memory")
#endif
#define PG8_WAIT_L(n) asm volatile("s_waitcnt lgkmcnt(" #n ")" ::: "memory")
#define PG8_BAR __builtin_amdgcn_s_barrier()
#define PG8_SCHED __builtin_amdgcn_sched_barrier(0)
    Unit cur, nxt;
    g.unit(j, cur);
    f32x4 acc[2][2][4][2];
#pragma unroll
    for (int a = 0; a < 2; ++a)
#pragma unroll
        for (int b = 0; b < 2; ++b)
#pragma unroll
            for (int m = 0; m < 4; ++m)
#pragma unroll
                for (int n = 0; n < 2; ++n) acc[a][b][m][n] = (f32x4){0.f, 0.f, 0.f, 0.f};
    bf16x8 At[4][2], B0[2][2], B1[2][2];
    const char* cA = cur.A; const char* cB = cur.B;
    PG8_STAGE(PG8_SB(0, 0), cB, voffB); PG8_STAGE(PG8_SB(0, 1), cB + hsB, voffB); PG8_STAGE(PG8_SA(0, 0), cA, voffA); PG8_STAGE(PG8_SA(0, 1), cA + hsA, voffA);
    if (wr == 1) PG8_BAR;
    PG8_WAIT_V(2); PG8_BAR;
    PG8_STAGE(PG8_SB(1, 0), cB + kstep, voffB); PG8_STAGE(PG8_SA(1, 0), cA + kstep, voffA); PG8_STAGE(PG8_SB(1, 1), cB + hsB + kstep, voffB);
    PG8_WAIT_V(6); PG8_BAR;
    for (;;) {
        const bool has_next = (j + Gn < count);
        if (has_next) g.unit(j + Gn, nxt);
        const char* nA = has_next ? nxt.A : cA; const char* nB = has_next ? nxt.B : cB;
        for (int t = 0; t < nt; t += 2) {
            const bool last = (t == nt - 2);
            const char* a1 = cA + (size_t)(t + 1) * kstep;
            const char* a2 = last ? nA : cA + (size_t)(t + 2) * kstep; const char* b2 = last ? nB : cB + (size_t)(t + 2) * kstep;
            const char* a3 = a2 + kstep; const char* b3 = b2 + kstep;
            PG8_LDB(B0, 0, 0); PG8_LDB(B1, 0, 1); PG8_SCHED; PG8_LDA(At, 0, 0); PG8_STAGE(PG8_SA(1, 1), a1 + hsA, voffA);
            PG8_WAIT_V(8); PG8_WAIT_L(0); PG8_BAR; PG8_MMA(0, 0, At, B0); PG8_MMA(0, 1, At, B1); PG8_BAR; PG8_SCHED;
            PG8_LDA(At, 0, 1); PG8_STAGE(PG8_SB(0, 0), b2, voffB); PG8_STAGE(PG8_SB(0, 1), b2 + hsB, voffB); PG8_STAGE(PG8_SA(0, 0), a2, voffA);
            PG8_WAIT_V(8); PG8_WAIT_L(0); PG8_BAR; PG8_MMA(1, 0, At, B0); PG8_MMA(1, 1, At, B1); PG8_BAR; PG8_SCHED;
            PG8_LDB(B0, 1, 0); PG8_LDB(B1, 1, 1); PG8_SCHED; PG8_LDA(At, 1, 0); PG8_STAGE(PG8_SA(0, 1), a2 + hsA, voffA);
            PG8_WAIT_V(8); PG8_WAIT_L(0); PG8_BAR; PG8_MMA(0, 0, At, B0); PG8_MMA(0, 1, At, B1); PG8_BAR; PG8_SCHED;
            PG8_LDA(At, 1, 1); PG8_STAGE(PG8_SB(1, 0), b3, voffB); PG8_STAGE(PG8_SB(1, 1), b3 + hsB, voffB); PG8_STAGE(PG8_SA(1, 0), a3, voffA);
            PG8_WAIT_V(8); PG8_WAIT_L(0); PG8_BAR; PG8_MMA(1, 0, At, B0); PG8_MMA(1, 1, At, B1); PG8_BAR; PG8_SCHED;
        }
        if (wr == 0) PG8_BAR;
        g.epi(acc, cur, wr, wc, fr, fq);
        if (!has_next) break;
#pragma unroll
        for (int a = 0; a < 2; ++a)
#pragma unroll
            for (int b = 0; b < 2; ++b)
#pragma unroll
                for (int m = 0; m < 4; ++m)
#pragma unroll
                    for (int n = 0; n < 2; ++n) acc[a][b][m][n] = (f32x4){0.f, 0.f, 0.f, 0.f};
        cur = nxt; cA = nA; cB = nB; j += Gn;
        if (wr == 1) PG8_BAR;
    }
    PG8_WAIT_V(0);
    PG8_BAR;
#undef PG8_SA
#undef PG8_SB
#undef PG8_STAGE
#undef PG8_LDA
#undef PG8_LDB
#undef PG8_MMA
#undef PG8_WAIT_V
#undef PG8_WAIT_L
#undef PG8_BAR
#undef PG8_SCHED
}

#define EPI_ARGS const f32x4 (&acc)[2][2][4][2], const Unit& u, int wr, int wc, int fr, int fq
struct G1a {
    static constexpr int K = 1024; static constexpr size_t HSA = 128 * 2048, HSB = 128 * 2048;
    const char* HB; const char* W; bf16_t* UH; bf16_t* SG;
    __device__ __forceinline__ unsigned offA(int R) const { return (unsigned)R * 2048u; }
    __device__ __forceinline__ unsigned offB(int R) const { return (unsigned)R * 2048u; }
    __device__ __forceinline__ void unit(int j, Unit& u) const { tile_of(j, 48, 10, u.pm, u.pn); u.A = HB + (size_t)u.pm * 256 * 2048; u.B = W + (size_t)u.pn * 256 * 2048; }
    __device__ __forceinline__ void epi(EPI_ARGS) const {
#pragma unroll
        for (int ai = 0; ai < 2; ++ai)
#pragma unroll
            for (int m = 0; m < 4; ++m) { const int t = u.pm * 256 + 128 * ai + 64 * wr + 16 * m + fr;
#pragma unroll
                for (int bj = 0; bj < 2; ++bj) { const int col = u.pn * 256 + 128 * bj + 32 * wc + 8 * fq; const f32x4 a = acc[ai][bj][m][0], b = acc[ai][bj][m][1];
                    if (u.pn < 2) { const int gg = col >> 4, h0 = col & 15; st16(UH + ((size_t)(gg * NCH + (t >> 4)) * 512 + (t & 15) * 16 + h0), pack8(a, b)); }
                    else { f32x4 sa, sb;
#pragma unroll
                        for (int q = 0; q < 4; ++q) { sa[q] = sigm(a[q]); sb[q] = sigm(b[q]); }
                        st16(SG + ((size_t)t * 2048 + (col - 512)), pack8(sa, sb)); } } }
    }
};
struct G1b {
    static constexpr int K = 1024; static constexpr size_t HSA = 128 * 2048, HSB = 2 * 2048;
    const char* HB; const char* W; bf16_t* XS;
    __device__ __forceinline__ unsigned offA(int R) const { return (unsigned)R * 2048u; }
    __device__ __forceinline__ unsigned offB(int R) const { return (unsigned)(64 * (R & 63) + (R >> 6)) * 2048u; }
    __device__ __forceinline__ void unit(int j, Unit& u) const { tile_of(j, 4, 32, u.pm, u.pn); u.A = W + (size_t)u.pm * 256 * 2048; const int s = u.pn >> 4, a0 = 4 * (u.pn & 15); u.B = HB + (size_t)(NTP + 4096 * s + a0) * 2048; }
    __device__ __forceinline__ void epi(EPI_ARGS) const {
        const int s = u.pn >> 4, a0 = 4 * (u.pn & 15);
#pragma unroll
        for (int ai = 0; ai < 2; ++ai)
#pragma unroll
            for (int m = 0; m < 4; ++m) { const int q = 64 * wr + 16 * m + fr, gq = u.pm * 128 + q;
#pragma unroll
                for (int bj = 0; bj < 2; ++bj) { const int la = a0 + 2 * bj + (wc >> 1), lb0 = 32 * (wc & 1) + 8 * fq;
                    const size_t idx = ((((size_t)((gq >> 1) * 2 + s) * 64 + la) * 2 + (gq & 1)) * 2 + ai) * 64 + lb0;
                    st16(XS + idx, pack8(acc[ai][bj][m][0], acc[ai][bj][m][1])); } }
    }
};
struct G1c {
    static constexpr int K = 1024; static constexpr size_t HSA = 128 * 2048, HSB = 128 * 2048;
    const char* HB; const char* W; bf16_t* XP;
    __device__ __forceinline__ unsigned offA(int R) const { return (unsigned)R * 2048u; }
    __device__ __forceinline__ unsigned offB(int R) const { return (unsigned)R * 2048u; }
    __device__ __forceinline__ void unit(int j, Unit& u) const { tile_of(j, 4, 16, u.pm, u.pn); u.A = W + (size_t)u.pm * 256 * 2048; u.B = HB + (size_t)(256 * u.pn) * 2048; }
    __device__ __forceinline__ void epi(EPI_ARGS) const {
#pragma unroll
        for (int ai = 0; ai < 2; ++ai)
#pragma unroll
            for (int m = 0; m < 4; ++m) { const int q = 64 * wr + 16 * m + fr, gq = u.pm * 128 + q;
#pragma unroll
                for (int bj = 0; bj < 2; ++bj) { const int l0 = 128 * bj + 32 * wc + 8 * fq;
                    const size_t idx = ((size_t)(u.pn * 512 + gq) * 2 + ai) * 256 + l0;
                    st16(XP + idx, pack8(acc[ai][bj][m][0], acc[ai][bj][m][1])); } }
    }
};
struct Gglu {
    static constexpr int K = 512; static constexpr size_t HSA = 128 * 1024, HSB = 128 * 1024;
    const char* ZB; const char* W; const float* bias; bf16_t* YS;
    __device__ __forceinline__ unsigned offA(int R) const { return (unsigned)R * 1024u; }
    __device__ __forceinline__ unsigned offB(int R) const { return (unsigned)R * 1024u; }
    __device__ __forceinline__ void unit(int j, Unit& u) const { tile_of(j, 48, 2, u.pm, u.pn); u.A = ZB + (size_t)u.pm * 256 * 1024; u.B = W + (size_t)u.pn * 256 * 1024; }
    __device__ __forceinline__ void epi(EPI_ARGS) const {
#pragma unroll
        for (int bj = 0; bj < 2; ++bj) { const int col = u.pn * 256 + 128 * bj + 32 * wc + 8 * fq;
            const f32x4 b0 = *(const f32x4*)(bias + col), b1 = *(const f32x4*)(bias + col + 4);
#pragma unroll
            for (int ai = 0; ai < 2; ++ai)
#pragma unroll
                for (int m = 0; m < 4; ++m) { const int t = u.pm * 256 + 128 * ai + 64 * wr + 16 * m + fr;
                    f32x4 z0, z1; unpack8(*(const u32x4*)((const bf16_t*)ZB + (size_t)t * 512 + col), z0, z1);
                    f32x4 a = acc[ai][bj][m][0] + b0, b = acc[ai][bj][m][1] + b1;
#pragma unroll
                    for (int q = 0; q < 4; ++q) { a[q] = z0[q] * sigm(a[q]); b[q] = z1[q] * sigm(b[q]); }
                    st16(YS + (size_t)t * 512 + col, pack8(a, b)); asm volatile("" ::: "memory"); } }
    }
};
struct Gps {
    static constexpr int K = 512; static constexpr size_t HSA = 128 * 1024, HSB = 128 * 1024;
    const char* A; const char* W; const bf16_t* SG; float* T1;
    __device__ __forceinline__ unsigned offA(int R) const { return (unsigned)R * 1024u; }
    __device__ __forceinline__ unsigned offB(int R) const { return (unsigned)R * 1024u; }
    __device__ __forceinline__ void unit(int j, Unit& u) const { tile_of(j, 48, 4, u.pm, u.pn); u.A = A + (size_t)u.pm * 256 * 1024; u.B = W + (size_t)u.pn * 256 * 1024; }
    __device__ __forceinline__ void epi(EPI_ARGS) const {
#pragma unroll
        for (int ai = 0; ai < 2; ++ai)
#pragma unroll
            for (int m = 0; m < 4; ++m) { const int t = u.pm * 256 + 128 * ai + 64 * wr + 16 * m + fr;
#pragma unroll
                for (int bj = 0; bj < 2; ++bj) { const int col = u.pn * 256 + 128 * bj + 32 * wc + 8 * fq;
                    f32x4 s0, s1; unpack8(*(const u32x4*)(SG + (size_t)t * 2048 + col), s0, s1);
                    st16f(T1 + (size_t)t * 1024 + col, s0 * acc[ai][bj][m][0]); st16f(T1 + (size_t)t * 1024 + col + 4, s1 * acc[ai][bj][m][1]); } asm volatile("" ::: "memory"); }
    }
};
struct Gpf {
    static constexpr int K = 512; static constexpr size_t HSA = 128 * 1024, HSB = 128 * 1024;
    const char* A; const char* W; const bf16_t* SG; const float* T1; bf16_t* MB;
    __device__ __forceinline__ unsigned offA(int R) const { return (unsigned)R * 1024u; }
    __device__ __forceinline__ unsigned offB(int R) const { return (unsigned)R * 1024u; }
    __device__ __forceinline__ void unit(int j, Unit& u) const { tile_of(j, 48, 4, u.pm, u.pn); u.A = A + (size_t)u.pm * 256 * 1024; u.B = W + (size_t)u.pn * 256 * 1024; }
    __device__ __forceinline__ void epi(EPI_ARGS) const {
#pragma unroll
        for (int ai = 0; ai < 2; ++ai)
#pragma unroll
            for (int m = 0; m < 4; ++m) { const int t = u.pm * 256 + 128 * ai + 64 * wr + 16 * m + fr;
#pragma unroll
                for (int bj = 0; bj < 2; ++bj) { const int col = u.pn * 256 + 128 * bj + 32 * wc + 8 * fq;
                    f32x4 s0, s1; unpack8(*(const u32x4*)(SG + (size_t)t * 2048 + 1024 + col), s0, s1);
                    const f32x4 t0 = *(const f32x4*)(T1 + (size_t)t * 1024 + col), t1 = *(const f32x4*)(T1 + (size_t)t * 1024 + col + 4);
                    st16(MB + (size_t)t * 1024 + col, pack8(t0 + s0 * acc[ai][bj][m][0], t1 + s1 * acc[ai][bj][m][1])); } asm volatile("" ::: "memory"); }
    }
};
struct Gwo {
    static constexpr int K = 1024; static constexpr size_t HSA = 128 * 2048, HSB = 128 * 2048;
    const char* A; const char* W; const float* xp; const float* xs; const float* MOD; const float* g2; float* X1; bf16_t* A2B; float* SSQ;
    __device__ __forceinline__ unsigned offA(int R) const { return (unsigned)R * 2048u; }
    __device__ __forceinline__ unsigned offB(int R) const { return (unsigned)R * 2048u; }
    __device__ __forceinline__ void unit(int j, Unit& u) const { tile_of(j, 48, 4, u.pm, u.pn); u.A = A + (size_t)u.pm * 256 * 2048; u.B = W + (size_t)u.pn * 256 * 2048; }
    __device__ __forceinline__ void epi(EPI_ARGS) const {
        const int mi = u.pm < 16 ? 0 : (u.pm < 32 ? 1 : 2);
        const float* xin = u.pm < 16 ? xp + (size_t)u.pm * 256 * 1024 : xs + (size_t)(u.pm - 16) * 256 * 1024;
        const float* md = MOD + mi * 6144;
        float ss[2][4];
#pragma unroll
        for (int ai = 0; ai < 2; ++ai)
#pragma unroll
            for (int m = 0; m < 4; ++m) ss[ai][m] = 0.f;
#pragma unroll
        for (int bj = 0; bj < 2; ++bj) { const int col = u.pn * 256 + 128 * bj + 32 * wc + 8 * fq;
            const f32x4 ga = *(const f32x4*)(md + 2048 + col), gb = *(const f32x4*)(md + 2048 + col + 4);
            const f32x4 sa = (*(const f32x4*)(md + 4096 + col) + 1.0f) * *(const f32x4*)(g2 + col), sb = (*(const f32x4*)(md + 4096 + col + 4) + 1.0f) * *(const f32x4*)(g2 + col + 4);
#pragma unroll
            for (int ai = 0; ai < 2; ++ai)
#pragma unroll
                for (int m = 0; m < 4; ++m) { const int rl = 128 * ai + 64 * wr + 16 * m + fr; const size_t t = (size_t)u.pm * 256 + rl;
                    const f32x4 x0 = *(const f32x4*)(xin + (size_t)rl * 1024 + col) + ga * acc[ai][bj][m][0], x1 = *(const f32x4*)(xin + (size_t)rl * 1024 + col + 4) + gb * acc[ai][bj][m][1];
                    st16f(X1 + t * 1024 + col, x0); st16f(X1 + t * 1024 + col + 4, x1);
                    st16(A2B + t * 1024 + col, pack8(x0 * sa, x1 * sb));
                    ss[ai][m] += (x0[0] * x0[0] + x0[1] * x0[1]) + (x0[2] * x0[2] + x0[3] * x0[3]) + (x1[0] * x1[0] + x1[1] * x1[1]) + (x1[2] * x1[2] + x1[3] * x1[3]);
                    asm volatile("" ::: "memory"); } }
#pragma unroll
        for (int ai = 0; ai < 2; ++ai)
#pragma unroll
            for (int m = 0; m < 4; ++m) { float s = ss[ai][m]; s += __shfl_xor(s, 16); s += __shfl_xor(s, 32);
                if (fq == 0) st4f(SSQ + ((size_t)u.pm * 256 + 128 * ai + 64 * wr + 16 * m + fr) * 16 + u.pn * 4 + wc, s); }
    }
};
struct Ggu {
    static constexpr int K = 1024; static constexpr size_t HSA = 128 * 2048, HSB = 128 * 2048;
    const char* A; const char* W; const float* SSQ; const float* SV; bf16_t* FF;
    __device__ __forceinline__ unsigned offA(int R) const { return (unsigned)R * 2048u; }
    __device__ __forceinline__ unsigned offB(int R) const { return (unsigned)R * 2048u; }
    __device__ __forceinline__ void unit(int j, Unit& u) const { tile_of(j, 48, 22, u.pm, u.pn); u.A = A + (size_t)u.pm * 256 * 2048; u.B = W + (size_t)u.pn * 256 * 2048; }
    __device__ __forceinline__ void epi(EPI_ARGS) const {
        const int mi = u.pm < 16 ? 0 : (u.pm < 32 ? 1 : 2);
        const float* sv = SV + mi * 5632 + u.pn * 256 + 32 * wc + 8 * fq;
        const f32x4 g0 = *(const f32x4*)(sv), g1 = *(const f32x4*)(sv + 4), u0 = *(const f32x4*)(sv + 128), u1 = *(const f32x4*)(sv + 132);
        const int col = u.pn * 128 + 32 * wc + 8 * fq;
#pragma unroll
        for (int ai = 0; ai < 2; ++ai)
#pragma unroll
            for (int m = 0; m < 4; ++m) { const size_t t = (size_t)u.pm * 256 + 128 * ai + 64 * wr + 16 * m + fr;
                const f32x4* sp = (const f32x4*)(SSQ + t * 16); const f32x4 q4 = (sp[0] + sp[1]) + (sp[2] + sp[3]);
                const float r = __builtin_amdgcn_rsqf(((q4[0] + q4[1]) + (q4[2] + q4[3])) * (1.0f / 1024.0f) + EPS);
                f32x4 ga = acc[ai][0][m][0] * r + g0, gb = acc[ai][0][m][1] * r + g1; const f32x4 ua = acc[ai][1][m][0] * r + u0, ub = acc[ai][1][m][1] * r + u1;
#pragma unroll
                for (int q = 0; q < 4; ++q) { ga[q] = ga[q] * sigm(ga[q]) * ua[q]; gb[q] = gb[q] * sigm(gb[q]) * ub[q]; }
                st16(FF + t * DFF + col, pack8(ga, gb)); asm volatile("" ::: "memory"); }
    }
};
struct Gdn {
    static constexpr int K = 2816; static constexpr size_t HSA = 128 * 5632, HSB = 128 * 5632;
    const char* A; const char* W; const float* X1; const float* MOD; float* OUT; float* SSQ;
    __device__ __forceinline__ unsigned offA(int R) const { return (unsigned)R * 5632u; }
    __device__ __forceinline__ unsigned offB(int R) const { return (unsigned)R * 5632u; }
    __device__ __forceinline__ void unit(int j, Unit& u) const { tile_of(j, 48, 4, u.pm, u.pn); u.A = A + (size_t)u.pm * 256 * 5632; u.B = W + (size_t)u.pn * 256 * 5632; }
    __device__ __forceinline__ void epi(EPI_ARGS) const {
        const int mi = u.pm < 16 ? 0 : (u.pm < 32 ? 1 : 2);
        const float* md = MOD + mi * 6144 + 5 * 1024;
        float ss[2][4];
#pragma unroll
        for (int ai = 0; ai < 2; ++ai)
#pragma unroll
            for (int m = 0; m < 4; ++m) ss[ai][m] = 0.f;
#pragma unroll
        for (int bj = 0; bj < 2; ++bj) { const int col = u.pn * 256 + 128 * bj + 32 * wc + 8 * fq;
            const f32x4 ga = *(const f32x4*)(md + col), gb = *(const f32x4*)(md + col + 4);
#pragma unroll
            for (int ai = 0; ai < 2; ++ai)
#pragma unroll
                for (int m = 0; m < 4; ++m) { const size_t t = (size_t)u.pm * 256 + 128 * ai + 64 * wr + 16 * m + fr;
                    const f32x4 x0 = *(const f32x4*)(X1 + t * 1024 + col) + ga * acc[ai][bj][m][0], x1 = *(const f32x4*)(X1 + t * 1024 + col + 4) + gb * acc[ai][bj][m][1];
                    st16f(OUT + t * 1024 + col, x0); st16f(OUT + t * 1024 + col + 4, x1);
                    ss[ai][m] += (x0[0] * x0[0] + x0[1] * x0[1]) + (x0[2] * x0[2] + x0[3] * x0[3]) + (x1[0] * x1[0] + x1[1] * x1[1]) + (x1[2] * x1[2] + x1[3] * x1[3]);
                    asm volatile("" ::: "memory"); } }
#pragma unroll
        for (int ai = 0; ai < 2; ++ai)
#pragma unroll
            for (int m = 0; m < 4; ++m) { float s = ss[ai][m]; s += __shfl_xor(s, 16); s += __shfl_xor(s, 32);
                if (fq == 0) st4f(SSQ + ((size_t)u.pm * 256 + 128 * ai + 64 * wr + 16 * m + fr) * 16 + u.pn * 4 + wc, s); }
    }
};

struct Params {
    const float* in[27];
    float* out;
    unsigned char* wsp;
};

__device__ __forceinline__ void transpose_item(const float* W, int ldw, int n0, int k0, bf16_t* WT, int drow, int Kd, LAS float* scr, int lane) {
#pragma unroll 8
    for (int i = 0; i < 32; ++i) { const int kk = 2 * i + (lane >> 5); scr[kk * 33 + (lane & 31)] = W[(size_t)(k0 + kk) * ldw + n0 + (lane & 31)]; }
    asm volatile("s_waitcnt lgkmcnt(0)" ::: "memory");
    const int c = lane & 7;
#pragma unroll
    for (int jj = 0; jj < 4; ++jj) { const int n = (lane >> 3) + 8 * jj; const LAS float* s = scr + (8 * c) * 33 + n;
        u32x4 o; o.x = cvt_pk_bf16(s[0 * 33], s[1 * 33]); o.y = cvt_pk_bf16(s[2 * 33], s[3 * 33]); o.z = cvt_pk_bf16(s[4 * 33], s[5 * 33]); o.w = cvt_pk_bf16(s[6 * 33], s[7 * 33]);
        *(u32x4*)(WT + (size_t)(drow + n) * Kd + k0 + 8 * c) = o; }
    asm volatile("s_waitcnt lgkmcnt(0)" ::: "memory");
}

__global__ void __launch_bounds__(512, 2) fwd_kernel(Params P) {
    extern __shared__ __attribute__((aligned(16))) unsigned char lds_raw[];
    LAS unsigned char* lds = (LAS unsigned char*)lds_raw;
    cg::grid_group grid = cg::this_grid();
#define GRID_SYNC() do { asm volatile("s_waitcnt vmcnt(0) lgkmcnt(0)" ::: "memory"); __builtin_amdgcn_fence(__ATOMIC_RELEASE, "agent"); asm volatile("s_waitcnt vmcnt(0)" ::: "memory"); grid.sync(); __builtin_amdgcn_fence(__ATOMIC_ACQUIRE, "agent"); asm volatile("s_waitcnt vmcnt(0)" ::: "memory"); } while (0)
#define FRESH_IDS int tid = threadIdx.x; asm volatile("" : "+v"(tid)); const int lane = tid & 63, wave = __builtin_amdgcn_readfirstlane(tid >> 6); \
    const int gw = blockIdx.x * 8 + wave, NGW = gridDim.x * 8; (void)lane; (void)gw; (void)NGW;
#define ws (P.wsp)
#define x_prompt (P.in[0])
#define x_sample (P.in[1])
#define state_s5 (P.in[2])
#define cvec (P.in[3])
#define c_ctx (P.in[4])
#define norm1_g (P.in[5])
#define norm2_g (P.in[6])
#define w_ada (P.in[7])
#define b_ada (P.in[8])
#define w_in (P.in[9])
#define lam_re (P.in[10])
#define lam_im (P.in[11])
#define log_step (P.in[12])
#define b_re (P.in[13])
#define b_im (P.in[14])
#define c_re (P.in[15])
#define c_im (P.in[16])
#define s5_d (P.in[17])
#define w_glu (P.in[18])
#define b_glu (P.in[19])
#define w_ps (P.in[20])
#define w_pf (P.in[21])
#define w_o (P.in[22])
#define w_g (P.in[23])
#define w_u (P.in[24])
#define w_d (P.in[25])
#define fin_g (P.in[26])
#define CTL ((unsigned*)(ws + WS_CTL))
#define MOD ((float*)(ws + WS_MOD))
#define SVGU ((float*)(ws + WS_SVGU))
#define MODP ((float*)(ws + WS_MODP))
#define SSQ2 ((float*)(ws + WS_SSQ2))
#define SSQ3 ((float*)(ws + WS_SSQ3))
#define W1T ((bf16_t*)(ws + WS_W1T))
#define WFT ((bf16_t*)(ws + WS_WFT))
#define WGLU ((bf16_t*)(ws + WS_WGLU))
#define WPS ((bf16_t*)(ws + WS_WPS))
#define WPF ((bf16_t*)(ws + WS_WPF))
#define WO ((bf16_t*)(ws + WS_WO))
#define WGU ((bf16_t*)(ws + WS_WGU))
#define WD ((bf16_t*)(ws + WS_WD))
#define SG ((bf16_t*)(ws + WS_R1))
#define X1 ((float*)(ws + WS_R1))
#define UH ((bf16_t*)(ws + WS_R3))
#define A2B ((bf16_t*)(ws + WS_R3))
#define T1 ((float*)(ws + WS_R3))
#define XS ((bf16_t*)(ws + WS_R4))
#define XP ((bf16_t*)(ws + WS_XP))
#define FF ((bf16_t*)(ws + WS_R4))
#define ZB ((bf16_t*)(ws + WS_R5))
#define YS ((bf16_t*)(ws + WS_YS))
#define YF ((bf16_t*)(ws + WS_YF))
#define HB ((bf16_t*)(ws + WS_R2))
#define YACC ((float*)(ws + WS_R2))
#define MB ((bf16_t*)(ws + WS_R2))
#define OUT (P.out)

    {
        FRESH_IDS
        if (blockIdx.x < 128) {
            LAS float* tile = (LAS float*)lds;
            LAS float* cs = tile + 32 * 132; LAS float* sn = cs + 128;
            const int gg = blockIdx.x >> 5, k0 = 32 * (blockIdx.x & 31);
            for (int idx = tid; idx < 32 * 32; idx += 512) { const int row = idx >> 5, c4 = idx & 31;
                const f32x4 v = *(const f32x4*)(w_in + (size_t)(k0 + row) * 3072 + 512 + 128 * gg + 4 * c4);
                *(LAS f32x4*)(tile + row * 132 + 4 * c4) = v; }
            if (tid < 128) { float s, c; sincos_frac(tid, 128, s, c); cs[tid] = c * 0.08838834764831845f; sn[tid] = s * 0.08838834764831845f; }
            __syncthreads();
            const int n = tid & 255, part = n >> 7, q = n & 127, kh = tid >> 8;
            float a[16];
#pragma unroll
            for (int i = 0; i < 16; ++i) a[i] = 0.f;
            const LAS float* tb = part ? sn : cs;
            for (int c = 0; c < 128; c += 4) {
                const float r0 = tb[(q * c) & 127], r1 = tb[(q * (c + 1)) & 127], r2 = tb[(q * (c + 2)) & 127], r3 = tb[(q * (c + 3)) & 127];
#pragma unroll
                for (int i = 0; i < 16; ++i) { const f32x4 w = *(const LAS f32x4*)(tile + (16 * kh + i) * 132 + c); a[i] += (w[0] * r0 + w[1] * r1) + (w[2] * r2 + w[3] * r3); }
            }
            bf16_t* dst = WFT + (size_t)(gg * 256 + n) * 1024 + k0 + 16 * kh;
            u32x4 o0, o1; o0.x = cvt_pk_bf16(a[0], a[1]); o0.y = cvt_pk_bf16(a[2], a[3]); o0.z = cvt_pk_bf16(a[4], a[5]); o0.w = cvt_pk_bf16(a[6], a[7]);
            o1.x = cvt_pk_bf16(a[8], a[9]); o1.y = cvt_pk_bf16(a[10], a[11]); o1.z = cvt_pk_bf16(a[12], a[13]); o1.w = cvt_pk_bf16(a[14], a[15]);
            st16(dst, o0); st16(dst + 8, o1);
            __syncthreads();
        }
        for (int tk = gw; tk < 768; tk += NGW) {
            const int cgp = tk % 24, kc = tk / 24;
            float sl0 = 0.f, sl1 = 0.f, sl2 = 0.f;
            if (lane < 32) { const int k = kc * 32 + lane; const float a = c_ctx[k], b = cvec[k], c = cvec[1024 + k]; sl0 = a * sigm(a); sl1 = b * sigm(b); sl2 = c * sigm(c); }
            f32x4 a0 = {0.f, 0.f, 0.f, 0.f}, a1 = a0, a2 = a0;
            const float* wp = w_ada + (size_t)(kc * 32) * 6144 + cgp * 256 + lane * 4;
#pragma unroll 8
            for (int kk = 0; kk < 32; ++kk) { const f32x4 w = *(const f32x4*)(wp + (size_t)kk * 6144);
                const float s0 = __shfl(sl0, kk), s1 = __shfl(sl1, kk), s2 = __shfl(sl2, kk);
                a0 += w * s0; a1 += w * s1; a2 += w * s2; }
            float* pp = MODP + (size_t)kc * 3 * 6144 + cgp * 256 + lane * 4;
            *(f32x4*)(pp) = a0; *(f32x4*)(pp + 6144) = a1; *(f32x4*)(pp + 2 * 6144) = a2;
        }
    }
    GRID_SYNC();
    {
        FRESH_IDS
        for (int tk = gw; tk < 24; tk += NGW) {
            const int col = tk * 256 + lane * 4;
            const f32x4 bv = *(const f32x4*)(b_ada + col);
            f32x4 r0 = bv, r1 = bv, r2 = bv;
            for (int k2 = 0; k2 < 32; ++k2) { const float* q = MODP + (size_t)k2 * 3 * 6144 + col;
                r0 += *(const f32x4*)q; r1 += *(const f32x4*)(q + 6144); r2 += *(const f32x4*)(q + 2 * 6144); }
            *(f32x4*)(MOD + col) = r0; *(f32x4*)(MOD + 6144 + col) = r1; *(f32x4*)(MOD + 2 * 6144 + col) = r2;
        }
        LAS float* scr = (LAS float*)(lds + 32768 + wave * 8704);
        for (int it = gw; it < 6656; it += NGW) {
            int r = it;
            if (r < 256) { const int kb = r / 16, nb = r % 16; transpose_item(w_in, 3072, 32 * nb, 64 * kb, W1T, 32 * nb, 1024, scr, lane); continue; } r -= 256;
            if (r < 1024) { const int kb = r / 64, nb = r % 64; transpose_item(w_in, 3072, 1024 + 32 * nb, 64 * kb, W1T, 512 + 32 * nb, 1024, scr, lane); continue; } r -= 1024;
            if (r < 128) { const int kb = r / 16, nb = r % 16; transpose_item(w_glu, 512, 32 * nb, 64 * kb, WGLU, 32 * nb, 512, scr, lane); continue; } r -= 128;
            if (r < 256) { const int kb = r / 32, nb = r % 32; transpose_item(w_ps, 1024, 32 * nb, 64 * kb, WPS, 32 * nb, 512, scr, lane); continue; } r -= 256;
            if (r < 256) { const int kb = r / 32, nb = r % 32; transpose_item(w_pf, 1024, 32 * nb, 64 * kb, WPF, 32 * nb, 512, scr, lane); continue; } r -= 256;
            if (r < 512) { const int kb = r / 32, nb = r % 32; transpose_item(w_o, 1024, 32 * nb, 64 * kb, WO, 32 * nb, 1024, scr, lane); continue; } r -= 512;
            if (r < 1408) { const int kb = r / 88, nb = r % 88, n0 = 32 * nb; transpose_item(w_g, 2816, n0, 64 * kb, WGU, 256 * (n0 >> 7) + (n0 & 127), 1024, scr, lane); continue; } r -= 1408;
            if (r < 1408) { const int kb = r / 88, nb = r % 88, n0 = 32 * nb; transpose_item(w_u, 2816, n0, 64 * kb, WGU, 256 * (n0 >> 7) + 128 + (n0 & 127), 1024, scr, lane); continue; } r -= 1408;
            { const int kb = r / 32, nb = r % 32; transpose_item(w_d, 1024, 32 * nb, 64 * kb, WD, 32 * nb, 2816, scr, lane); }
        }
    }
    GRID_SYNC();
    {
        FRESH_IDS
        for (int t = gw; t < NT; t += NGW) {
            const float* xr = t < NTP ? x_prompt + (size_t)t * 1024 : x_sample + (size_t)(t - NTP) * 1024;
            const int mi = t < NTP ? 0 : (t < NTP + 4096 ? 1 : 2);
            const float* md = MOD + mi * 6144;
            f32x4 v[4]; float s = 0.f;
#pragma unroll
            for (int jx = 0; jx < 4; ++jx) { v[jx] = *(const f32x4*)(xr + 4 * lane + 256 * jx); s += (v[jx][0] * v[jx][0] + v[jx][1] * v[jx][1]) + (v[jx][2] * v[jx][2] + v[jx][3] * v[jx][3]); }
            const float r = 1.0f / sqrtf(wave_sum(s) * (1.0f / 1024.0f) + EPS);
#pragma unroll
            for (int jx = 0; jx < 4; ++jx) { const int col = 4 * lane + 256 * jx;
                const f32x4 gs = *(const f32x4*)(norm1_g + col) * (*(const f32x4*)(md + 1024 + col) + 1.0f), sh = *(const f32x4*)(md + col);
                const f32x4 h = v[jx] * r * gs + sh;
                u32x2 o; o.x = cvt_pk_bf16(h[0], h[1]); o.y = cvt_pk_bf16(h[2], h[3]);
                *(u32x2*)(HB + (size_t)t * 1024 + col) = o; }
        }
        for (int n = gw; n < 5632; n += NGW) {
            const u32x4 w0 = *(const u32x4*)(WGU + (size_t)n * 1024 + 16 * lane), w1 = *(const u32x4*)(WGU + (size_t)n * 1024 + 16 * lane + 8);
            f32x4 wa, wb, wc4, wd; unpack8(w0, wa, wb); unpack8(w1, wc4, wd);
#pragma unroll
            for (int mi = 0; mi < 3; ++mi) { const float* sh = MOD + mi * 6144 + 3 * 1024 + 16 * lane;
                const f32x4 s0 = *(const f32x4*)(sh), s1 = *(const f32x4*)(sh + 4), s2 = *(const f32x4*)(sh + 8), s3 = *(const f32x4*)(sh + 12);
                const f32x4 p = wa * s0 + wb * s1 + wc4 * s2 + wd * s3;
                const float d = wave_sum((p[0] + p[1]) + (p[2] + p[3]));
                if (lane == 0) st4f(SVGU + mi * 5632 + n, d); }
        }
    }
    GRID_SYNC();
#if DBG_STOP == 2
    { FRESH_IDS
      for (size_t i = (size_t)blockIdx.x * 512 + tid; i < (size_t)NT * 1024; i += (size_t)gridDim.x * 512) { const size_t c = i & 1023; OUT[i] = bf2f(HB[i]) + 0.25f * (bf2f(W1T[i % (2560 * 1024)]) + bf2f(WFT[i % (1024 * 1024)]) + bf2f(WGU[i % (5632 * 1024)]) + bf2f(WD[i % (2816 * 1024)])) + MOD[i % 18432]; (void)c; }
      for (size_t i = (size_t)blockIdx.x * 512 + tid; i < 131072; i += (size_t)gridDim.x * 512) { OUT[(size_t)NT * 1024 + i] = SVGU[i % 16896] + bf2f(WGLU[i]) + bf2f(WPS[i]) + bf2f(WPF[i]) + bf2f(WO[i]); }
      return; }
#endif
    { G1a g{(const char*)HB, (const char*)W1T, UH, SG}; gemm_phase(lds, g, 0, 480); }
    { G1b g{(const char*)HB, (const char*)WFT, XS}; gemm_phase(lds, g, 480, 128); }
    { G1c g{(const char*)HB, (const char*)WFT, XP}; gemm_phase(lds, g, 608, 64); }
    GRID_SYNC();
#if DBG_STOP == 1
    { FRESH_IDS
      for (size_t i = (size_t)blockIdx.x * 512 + tid; i < (size_t)NT * 1024; i += (size_t)gridDim.x * 512) { const size_t t = i >> 10, c = i & 1023; OUT[i] = bf2f(SG[t * 2048 + c]) + bf2f(SG[t * 2048 + 1024 + c]); }
      for (size_t i = (size_t)blockIdx.x * 512 + tid; i < 131072; i += (size_t)gridDim.x * 512) { float a = 0.f; for (int r = 0; r < 64; ++r) a += bf2f(XS[i * 64 + r]) + bf2f(XP[i * 32 + (r & 31)]); const size_t u = i * 48; const size_t row = u >> 8, cc = u & 255; a += bf2f(UH[row * 512 + cc]); OUT[(size_t)NT * 1024 + i] = a; }
      return; }
#endif
    {
        FRESH_IDS
        for (int tk = gw; tk < 18 * 32; tk += NGW) {
            const int seq = tk >> 5, gg = tk & 31;
            const int L = seq < 16 ? 256 : 4096, tok0 = seq < 16 ? 256 * seq : NTP + 4096 * (seq - 16);
            for (int d = 0; d < 2; ++d) {
                const int pi = (d * 32 + gg) * 64 + lane;
                const float lr = lam_re[pi], li = lam_im[pi], step = __expf(log_step[d * 32 + gg]);
                double sd, cd; sincos_d((double)(li * step), sd, cd);
                const float mag = __expf(lr * step), are = mag * (float)cd, aim = mag * (float)sd;
                const float nr = are - 1.0f, ni = aim, den = lr * lr + li * li, fr_ = (nr * lr + ni * li) / den, fi_ = (ni * lr - nr * li) / den;
                float Bre[16], Bim[16], Cre[16], Cim[16];
#pragma unroll
                for (int h = 0; h < 16; ++h) { const float br = b_re[(size_t)pi * 16 + h], bi = b_im[(size_t)pi * 16 + h]; Bre[h] = fr_ * br - fi_ * bi; Bim[h] = fr_ * bi + fi_ * br;
                    Cre[h] = c_re[((size_t)(d * 32 + gg) * 16 + h) * 64 + lane]; Cim[h] = c_im[((size_t)(d * 32 + gg) * 16 + h) * 64 + lane]; }
                float sre = 0.f, sim = 0.f;
                if (seq >= 16) { const int sb = seq - 16; sre = state_s5[(((size_t)sb * 2 + d) * 2 + 0) * 2048 + gg * 64 + lane]; sim = state_s5[(((size_t)sb * 2 + d) * 2 + 1) * 2048 + gg * 64 + lane]; }
                const float dcoef = lane < 16 ? s5_d[16 * gg + lane] : 0.f;
                for (int i = 0; i < L; ++i) {
                    const int l = d ? (L - 1 - i) : i, t = tok0 + l;
                    const bf16_t* up = UH + ((size_t)(gg * NCH + (t >> 4)) * 512 + (t & 15) * 16);
                    const u32x4 w0 = *(const u32x4*)up, w1 = *(const u32x4*)(up + 8);
                    f32x4 u0, u1, u2, u3; unpack8(w0, u0, u1); unpack8(w1, u2, u3);
                    float uu[16] = {u0[0], u0[1], u0[2], u0[3], u1[0], u1[1], u1[2], u1[3], u2[0], u2[1], u2[2], u2[3], u3[0], u3[1], u3[2], u3[3]};
                    float bre = 0.f, bim = 0.f;
#pragma unroll
                    for (int h = 0; h < 16; ++h) { bre += Bre[h] * uu[h]; bim += Bim[h] * uu[h]; }
                    const float nre = are * sre - aim * sim + bre, nim = are * sim + aim * sre + bim; sre = nre; sim = nim;
                    float mine = 0.f, myu = 0.f;
#pragma unroll
                    for (int h = 0; h < 16; ++h) { const float v = wave_sum(Cre[h] * sre - Cim[h] * sim); if (lane == h) { mine = v; myu = uu[h]; } }
                    if (lane < 16) {
                        float* ya = YACC + (size_t)t * 512 + 16 * gg + lane;
                        if (d == 0) *ya = mine + dcoef * myu;
                        else { const float y = *ya + mine; st2(ZB + (size_t)t * 512 + 16 * gg + lane, cvt_pk_bf16(gelu_tanh(y), 0.f)); }
                    }
                }
                if (seq < 16) { float* ns = OUT + (size_t)NT * 1024 + (((size_t)seq * 2 + d) * 2) * 2048 + gg * 64 + lane; ns[0] = sre; ns[2048] = sim; }
            }
        }
        __syncthreads();
        {
            LAS f32x2* tab = (LAS f32x2*)lds;
            for (int i = tid; i < 4096; i += 512) { float s, c; sincos_frac(i, 4096, s, c); tab[i] = (f32x2){c, s}; }
            __syncthreads();
            for (int tk = blockIdx.x; tk < 2 * 512 * 8; tk += gridDim.x) {
                const int kb = tk & 7, gq = (tk >> 3) & 511, s = tk >> 12, k = kb * 512 + tid;
                float accv = 0.f;
                for (int la = 0; la < 64; ++la) {
                    const bf16_t* pp = XS + ((((size_t)((gq >> 1) * 2 + s) * 64 + la) * 2 + (gq & 1)) * 2) * 64;
                    for (int lb = 0; lb < 64; ++lb) { const int l = 64 * lb + la; const f32x2 cs = tab[(k * l) & 4095];
                        accv += cs[0] * bf2f(pp[lb]) - cs[1] * bf2f(pp[64 + lb]); }
                }
                st2(YF + (size_t)(NTP + 4096 * s + k) * 512 + gq, cvt_pk_bf16(accv * 0.015625f, 0.f));
            }
            for (int tk = blockIdx.x; tk < 16 * 256; tk += gridDim.x) {
                const int b = tk >> 8, gq = 2 * (tk & 255) + (tid >> 8), k = tid & 255;
                const bf16_t* pp = XP + ((size_t)(b * 512 + gq) * 2) * 256;
                float accv = 0.f;
                for (int l = 0; l < 256; ++l) { const f32x2 cs = tab[((k * l) & 255) * 16]; accv += cs[0] * bf2f(pp[l]) - cs[1] * bf2f(pp[256 + l]); }
                st2(YF + (size_t)(256 * b + k) * 512 + gq, cvt_pk_bf16(accv * 0.0625f, 0.f));
            }
        }
    }
    GRID_SYNC();
    { Gglu g{(const char*)ZB, (const char*)WGLU, b_glu, YS}; gemm_phase(lds, g, 0, 96); }
    GRID_SYNC();
    { Gps g{(const char*)YS, (const char*)WPS, SG, T1}; gemm_phase(lds, g, 0, 192); }
    { Gpf g{(const char*)YF, (const char*)WPF, SG, T1, MB}; gemm_phase(lds, g, 0, 192); }
    GRID_SYNC();
    { Gwo g{(const char*)MB, (const char*)WO, x_prompt, x_sample, MOD, norm2_g, X1, A2B, SSQ2}; gemm_phase(lds, g, 0, 192); }
    GRID_SYNC();
    { Ggu g{(const char*)A2B, (const char*)WGU, SSQ2, SVGU, FF}; gemm_phase(lds, g, 0, 1056); }
    GRID_SYNC();
    { Gdn g{(const char*)FF, (const char*)WD, X1, MOD, OUT, SSQ3}; gemm_phase(lds, g, 0, 192); }
    GRID_SYNC();
    { FRESH_IDS
    for (int t = gw; t < NT; t += NGW) {
        const f32x4* sp = (const f32x4*)(SSQ3 + (size_t)t * 16); const f32x4 q4 = (sp[0] + sp[1]) + (sp[2] + sp[3]);
        const float r = 1.0f / sqrtf(((q4[0] + q4[1]) + (q4[2] + q4[3])) * (1.0f / 1024.0f) + EPS);
        float* row = OUT + (size_t)t * 1024;
#pragma unroll
        for (int jx = 0; jx < 4; ++jx) { const int col = 4 * lane + 256 * jx; *(f32x4*)(row + col) = *(const f32x4*)(row + col) * r * *(const f32x4*)(fin_g + col); }
    } }
}

#undef ws
#undef OUT
constexpr int LDS_BYTES = 8 * HTB + 1024;

extern "C" void kernel_launch(void* const* d_in, const int* in_sizes, int n_in, void* d_out, int out_size, void* d_ws, size_t ws_size, hipStream_t stream) {
    static int grid = 0;
    if (grid == 0) {
        int dev = 0, cus = 0, per_cu = 0;
        hipGetDevice(&dev);
        hipDeviceGetAttribute(&cus, hipDeviceAttributeMultiprocessorCount, dev);
        if (hipFuncSetAttribute((const void*)fwd_kernel, hipFuncAttributeMaxDynamicSharedMemorySize, LDS_BYTES) != hipSuccess) fprintf(stderr, "hipFuncSetAttribute failed\n");
        if (hipOccupancyMaxActiveBlocksPerMultiprocessor(&per_cu, (const void*)fwd_kernel, 512, LDS_BYTES) != hipSuccess || per_cu < 1) { fprintf(stderr, "occupancy query: %d\n", per_cu); per_cu = 1; }
        (void)hipGetLastError();
        grid = cus > 0 ? cus : 256;
        if (ws_size < WS_END) fprintf(stderr, "workspace too small: %zu < %zu\n", ws_size, (size_t)WS_END);
    }
    hipMemsetAsync((char*)d_ws + WS_CTL, 0, 4096, stream);
    Params p{};
    for (int i = 0; i < 27; ++i) p.in[i] = (const float*)d_in[i];
    p.out = (float*)d_out; p.wsp = (unsigned char*)d_ws;
    void* args[] = {&p};
    hipError_t e = hipLaunchCooperativeKernel((const void*)fwd_kernel, dim3(grid), dim3(512), args, LDS_BYTES, stream);
    if (e != hipSuccess) fprintf(stderr, "cooperative launch failed: %s (grid %d)\n", hipGetErrorString(e), grid);
}
```

```cpp
#include <hip/hip_runtime.h>
#include <hip/hip_cooperative_groups.h>
#include <cstdio>
#include <cstdint>
namespace cg = cooperative_groups;

#define LAS __attribute__((address_space(3)))
typedef unsigned short bf16_t;
typedef short bf16x8 __attribute__((ext_vector_type(8)));
typedef float f32x4 __attribute__((ext_vector_type(4)));
typedef float f32x2 __attribute__((ext_vector_type(2)));
typedef unsigned u32x4 __attribute__((ext_vector_type(4)));
typedef unsigned u32x2 __attribute__((ext_vector_type(2)));

#ifndef DBG_STOP
#define DBG_STOP 0
#endif
constexpr int NT = 12288, NTP = 4096, DM = 1024, NCH = 768, DFF = 2816;
constexpr float EPS = 1e-6f;

constexpr size_t AL(size_t x) { return (x + 255) & ~(size_t)255; }
constexpr size_t WS_CTL = 0;
constexpr size_t WS_MOD = 4096;
constexpr size_t WS_SVGU = WS_MOD + AL(3 * 6144 * 4);
constexpr size_t WS_MODP = AL(WS_SVGU + 3 * 5632 * 4);
constexpr size_t WS_SSQ2 = AL(WS_MODP + 32 * 3 * 6144 * 4);
constexpr size_t WS_SSQ3 = AL(WS_SSQ2 + (size_t)NT * 16 * 4);
constexpr size_t WS_W1T = AL(WS_SSQ3 + (size_t)NT * 16 * 4);
constexpr size_t WS_WFT = WS_W1T + 2560 * 1024 * 2;
constexpr size_t WS_WGLU = WS_WFT + 1024 * 1024 * 2;
constexpr size_t WS_WPS = WS_WGLU + 512 * 512 * 2;
constexpr size_t WS_WPF = WS_WPS + 1024 * 512 * 2;
constexpr size_t WS_WO = WS_WPF + 1024 * 512 * 2;
constexpr size_t WS_WGU = WS_WO + 1024 * 1024 * 2;
constexpr size_t WS_WD = WS_WGU + (size_t)5632 * 1024 * 2;
constexpr size_t WS_R1 = AL(WS_WD + (size_t)1024 * 2816 * 2);
constexpr size_t WS_R3 = WS_R1 + (size_t)NT * 2048 * 2;
constexpr size_t WS_R4 = WS_R3 + (size_t)NT * 1024 * 2;
constexpr size_t WS_XP = WS_R4 + (size_t)16777216;
constexpr size_t WS_R5 = WS_R4 + (size_t)NT * 1024 * 2;
constexpr size_t WS_YS = WS_R5 + (size_t)NT * 512 * 2;
constexpr size_t WS_YF = WS_YS + (size_t)NT * 512 * 2;
constexpr size_t WS_R2 = WS_YF + (size_t)NT * 512 * 2;
constexpr size_t WS_SF = WS_R2 + (size_t)NT * 1024 * 2;
constexpr size_t WS_ME = WS_SF + (size_t)32 * 256 * 256 * 2;
constexpr size_t WS_KK = WS_ME + (size_t)32 * 256 * 512 * 2;
constexpr size_t WS_A16 = WS_KK + (size_t)32 * 2 * 4096 * 4;
constexpr size_t WS_D1 = WS_A16 + 32 * 2 * 64 * 8;
constexpr size_t WS_D2 = WS_D1 + 256 * 256 * 2;
constexpr size_t WS_DP = WS_D2 + 256 * 512 * 2;
constexpr size_t WS_TW = WS_DP + 256 * 512 * 2;
constexpr size_t WS_END = WS_TW + 64 * 64 * 8;

__device__ __forceinline__ unsigned cvt_pk_bf16(float lo, float hi) { unsigned r; asm volatile("v_cvt_pk_bf16_f32 %0, %1, %2" : "=v"(r) : "v"(lo), "v"(hi)); return r; }
__device__ __forceinline__ float bf2f(unsigned short b) { return __uint_as_float(((unsigned)b) << 16); }
__device__ __forceinline__ float bflo(unsigned w) { return __uint_as_float(w << 16); }
__device__ __forceinline__ float bfhi(unsigned w) { return __uint_as_float(w & 0xffff0000u); }
__device__ __forceinline__ float sigm(float x) { return __builtin_amdgcn_rcpf(1.0f + __expf(-x)); }
__device__ __forceinline__ float gelu_tanh(float x) { const float u = 0.7978845608028654f * (x + 0.044715f * x * x * x); return x * sigm(2.0f * u); }
__device__ __forceinline__ float wave_sum(float v) {
#pragma unroll
    for (int o = 1; o < 64; o <<= 1) v += __shfl_xor(v, o);
    return v;
}
__device__ __forceinline__ void st16(void* p, u32x4 v) { asm volatile("global_store_dwordx4 %0, %1, off sc1\n\ts_nop 1" :: "v"(p), "v"(v) : "memory"); }
__device__ __forceinline__ void st16f(void* p, f32x4 v) { asm volatile("global_store_dwordx4 %0, %1, off sc1\n\ts_nop 1" :: "v"(p), "v"(v) : "memory"); }
__device__ __forceinline__ void st4f(float* p, float v) { asm volatile("global_store_dword %0, %1, off sc1\n\ts_nop 1" :: "v"(p), "v"(v) : "memory"); }
__device__ __forceinline__ void st2(bf16_t* p, unsigned v) { asm volatile("global_store_short %0, %1, off sc1\n\ts_nop 1" :: "v"(p), "v"(v) : "memory"); }
__device__ __forceinline__ u32x4 pack8(f32x4 a, f32x4 b) { u32x4 w; w.x = cvt_pk_bf16(a[0], a[1]); w.y = cvt_pk_bf16(a[2], a[3]); w.z = cvt_pk_bf16(b[0], b[1]); w.w = cvt_pk_bf16(b[2], b[3]); return w; }
__device__ __forceinline__ void unpack8(u32x4 w, f32x4& a, f32x4& b) { a = (f32x4){bflo(w.x), bfhi(w.x), bflo(w.y), bfhi(w.y)}; b = (f32x4){bflo(w.z), bfhi(w.z), bflo(w.w), bfhi(w.w)}; }
__device__ __forceinline__ void sincos_d(double th, double& s, double& c) {
    const double k = rint(th * 0.63661977236758134308);
    const double r = fma(-k, 6.123233995736766e-17, fma(-k, 1.5707963267948966, th));
    const double x2 = r * r;
    double sp = -7.6471637318198165e-13; sp = sp * x2 + 1.6059043836821613e-10; sp = sp * x2 - 2.5052108385441719e-08; sp = sp * x2 + 2.7557319223985891e-06;
    sp = sp * x2 - 1.9841269841269841e-04; sp = sp * x2 + 8.3333333333333333e-03; sp = sp * x2 - 1.6666666666666667e-01; sp = r + r * x2 * sp;
    double cp = 4.7794773323873853e-14; cp = cp * x2 - 1.1470745597729725e-11; cp = cp * x2 + 2.0876756987868099e-09; cp = cp * x2 - 2.7557319223985891e-07;
    cp = cp * x2 + 2.4801587301587302e-05; cp = cp * x2 - 1.3888888888888889e-03; cp = cp * x2 + 4.1666666666666667e-02; cp = cp * x2 - 0.5; cp = 1.0 + x2 * cp;
    const int q = ((int)k) & 3;
    s = (q == 0) ? sp : (q == 1) ? cp : (q == 2) ? -sp : -cp;
    c = (q == 0) ? cp : (q == 1) ? -sp : (q == 2) ? -cp : sp;
}
__device__ __forceinline__ void sincos_frac(int j, int N, float& s, float& c) { double ds, dc; sincos_d(6.283185307179586476925 * (double)(j & (N - 1)) / (double)N, ds, dc); s = (float)ds; c = (float)dc; }

constexpr int HTB = 128 * 64 * 2;
__device__ __forceinline__ int lds_byte(int r, int c) { const int st = (r >> 4) * 2 + (c >> 5), rr = r & 15, cc = c & 31, ob = rr * 64 + cc * 2; return st * 1024 + (ob ^ (((ob >> 9) & 1) << 5)); }
__device__ __forceinline__ void stage_rc(int b, int& R, int& C) { const int st = b / 1024, sb = b % 1024, swz = sb ^ (((sb >> 9) & 1) << 5); R = (st >> 1) * 16 + swz / 64; C = (st & 1) * 32 + (swz % 64) / 2; }
__device__ __forceinline__ int perm32(int rho) { const int n = rho >> 4, i = rho & 15; return 8 * (i >> 2) + 4 * n + (i & 3); }
struct Unit { const char* A; const char* B; int pm, pn; };
__device__ __forceinline__ void tile_of(int j, int nM, int nN, int& pm, int& pn) {
    const int nwg = nM * nN; int wgid = j;
    { const int q = nwg / 8, r = nwg % 8, xcd = wgid % 8, off = wgid / 8; wgid = (xcd < r ? xcd * (q + 1) : r * (q + 1) + (xcd - r) * q) + off; }
    const int nig = 8 * nN, gid = wgid / nig, fm = gid * 8, gsz = (nM - fm) < 8 ? (nM - fm) : 8;
    pm = fm + ((wgid % nig) % gsz); pn = (wgid % nig) / gsz;
}
template <class G>
__device__ __forceinline__ void gemm_phase(LAS unsigned char* lds, const G& g, const int L0, const int count) {
    constexpr int K = G::K, nt = K / 64;
    static_assert(nt % 2 == 0 && nt >= 2, "K");
    int tid = threadIdx.x; asm volatile("" : "+v"(tid));
    const int wid = __builtin_amdgcn_readfirstlane(tid >> 6), lane = tid & 63, wr = wid >> 2, wc = wid & 3, fr = lane & 15, fq = lane >> 4;
    const int Gn = gridDim.x;
    int j = ((int)blockIdx.x - L0) % Gn; if (j < 0) j += Gn;
    if (j >= count) return;
    unsigned voffA[2], voffB[2];
#pragma unroll
    for (int i = 0; i < 2; ++i) { int R, C; stage_rc(tid * 16 + i * 8192, R, C); const int Rb = (R & ~31) + perm32(R & 31);
        voffA[i] = g.offA(R) + (unsigned)C * 2u; voffB[i] = g.offB(Rb) + (unsigned)C * 2u; }
    const size_t kstep = 128, hsA = G::HSA, hsB = G::HSB;
    const unsigned ldsw = (unsigned)wid * 1024u;
    const int aoff = lds_byte(wr * 64 + fr, fq * 8), boff = lds_byte(wc * 32 + fr, fq * 8);
#define PG8_SA(b, h) (((b) * 2 + (h)) * HTB)
#define PG8_SB(b, h) ((4 + (b) * 2 + (h)) * HTB)
#define PG8_STAGE(bufoff, gbase, voff) do { _Pragma("unroll") for (int _i = 0; _i < 2; ++_i) \
        __builtin_amdgcn_global_load_lds((const unsigned*)((const char*)(gbase) + (voff)[_i]), (LAS unsigned*)(lds + (bufoff) + ldsw + _i * 8192), 16, 0, 0); } while (0)
#define PG8_LDA(dst, b, h) do { _Pragma("unroll") for (int m = 0; m < 4; ++m) _Pragma("unroll") for (int k = 0; k < 2; ++k) dst[m][k] = *(const LAS bf16x8*)(lds + PG8_SA(b, h) + aoff + m * 2048 + k * 1024); } while (0)
#define PG8_LDB(dst, b, h) do { _Pragma("unroll") for (int n = 0; n < 2; ++n) _Pragma("unroll") for (int k = 0; k < 2; ++k) dst[n][k] = *(const LAS bf16x8*)(lds + PG8_SB(b, h) + boff + n * 2048 + k * 1024); } while (0)
#define PG8_MMA(ai, bj, At, Bt) do { __builtin_amdgcn_s_setprio(1); _Pragma("unroll") for (int m = 0; m < 4; ++m) _Pragma("unroll") for (int n = 0; n < 2; ++n) _Pragma("unroll") for (int k = 0; k < 2; ++k) \
        acc[ai][bj][m][n] = __builtin_amdgcn_mfma_f32_16x16x32_bf16(Bt[n][k], At[m][k], acc[ai][bj][m][n], 0, 0, 0); __builtin_amdgcn_s_setprio(0); } while (0)
#ifdef SAFE_ENGINE
#define PG8_WAIT_V(n) asm volatile("s_waitcnt vmcnt(0)" ::: "memory")
#else
#define PG8_WAIT_V(n) asm volatile("s_waitcnt vmcnt(" #n ")" ::: "memory")
#endif
#define PG8_WAIT_L(n) asm volatile("s_waitcnt lgkmcnt(" #n ")" ::: "memory")
#define PG8_BAR __builtin_amdgcn_s_barrier()
#define PG8_SCHED __builtin_amdgcn_sched_barrier(0)
    Unit cur, nxt;
    g.unit(j, cur); asm volatile("" : "+s"(cur.A), "+s"(cur.B));
    f32x4 acc[2][2][4][2];
#pragma unroll
    for (int a = 0; a < 2; ++a)
#pragma unroll
        for (int b = 0; b < 2; ++b)
#pragma unroll
            for (int m = 0; m < 4; ++m)
#pragma unroll
                for (int n = 0; n < 2; ++n) acc[a][b][m][n] = (f32x4){0.f, 0.f, 0.f, 0.f};
    bf16x8 At[4][2], B0[2][2], B1[2][2];
    const char* cA = cur.A; const char* cB = cur.B;
    PG8_STAGE(PG8_SB(0, 0), cB, voffB); PG8_STAGE(PG8_SB(0, 1), cB + hsB, voffB); PG8_STAGE(PG8_SA(0, 0), cA, voffA); PG8_STAGE(PG8_SA(0, 1), cA + hsA, voffA);
    if (wr == 1) PG8_BAR;
    PG8_WAIT_V(2); PG8_BAR;
    PG8_STAGE(PG8_SB(1, 0), cB + kstep, voffB); PG8_STAGE(PG8_SA(1, 0), cA + kstep, voffA); PG8_STAGE(PG8_SB(1, 1), cB + hsB + kstep, voffB);
    PG8_WAIT_V(6); PG8_BAR;
    for (;;) {
        const bool has_next = (j + Gn < count);
        if (has_next) { g.unit(j + Gn, nxt); asm volatile("" : "+s"(nxt.A), "+s"(nxt.B)); }
        const char* nA = has_next ? nxt.A : cA; const char* nB = has_next ? nxt.B : cB;
        for (int t = 0; t < nt; t += 2) {
            const bool last = (t == nt - 2);
            const char* a1 = cA + (size_t)(t + 1) * kstep;
            const char* a2 = last ? nA : cA + (size_t)(t + 2) * kstep; const char* b2 = last ? nB : cB + (size_t)(t + 2) * kstep;
            const char* a3 = a2 + kstep; const char* b3 = b2 + kstep;
            PG8_LDB(B0, 0, 0); PG8_LDB(B1, 0, 1); PG8_SCHED; PG8_LDA(At, 0, 0); PG8_STAGE(PG8_SA(1, 1), a1 + hsA, voffA);
            PG8_WAIT_V(8); PG8_WAIT_L(0); PG8_BAR; PG8_MMA(0, 0, At, B0); PG8_MMA(0, 1, At, B1); PG8_BAR; PG8_SCHED;
            PG8_LDA(At, 0, 1); PG8_STAGE(PG8_SB(0, 0), b2, voffB); PG8_STAGE(PG8_SB(0, 1), b2 + hsB, voffB); PG8_STAGE(PG8_SA(0, 0), a2, voffA);
            PG8_WAIT_V(8); PG8_WAIT_L(0); PG8_BAR; PG8_MMA(1, 0, At, B0); PG8_MMA(1, 1, At, B1); PG8_BAR; PG8_SCHED;
            PG8_LDB(B0, 1, 0); PG8_LDB(B1, 1, 1); PG8_SCHED; PG8_LDA(At, 1, 0); PG8_STAGE(PG8_SA(0, 1), a2 + hsA, voffA);
            PG8_WAIT_V(8); PG8_WAIT_L(0); PG8_BAR; PG8_MMA(0, 0, At, B0); PG8_MMA(0, 1, At, B1); PG8_BAR; PG8_SCHED;
            PG8_LDA(At, 1, 1); PG8_STAGE(PG8_SB(1, 0), b3, voffB); PG8_STAGE(PG8_SB(1, 1), b3 + hsB, voffB); PG8_STAGE(PG8_SA(1, 0), a3, voffA);
            PG8_WAIT_V(8); PG8_WAIT_L(0); PG8_BAR; PG8_MMA(1, 0, At, B0); PG8_MMA(1, 1, At, B1); PG8_BAR; PG8_SCHED;
        }
        if (wr == 0) PG8_BAR;
        g.epi(acc, cur, wr, wc, fr, fq);
        if (!has_next) break;
#pragma unroll
        for (int a = 0; a < 2; ++a)
#pragma unroll
            for (int b = 0; b < 2; ++b)
#pragma unroll
                for (int m = 0; m < 4; ++m)
#pragma unroll
                    for (int n = 0; n < 2; ++n) acc[a][b][m][n] = (f32x4){0.f, 0.f, 0.f, 0.f};
        cur = nxt; cA = nA; cB = nB; j += Gn;
        if (wr == 1) PG8_BAR;
    }
    PG8_WAIT_V(0);
    PG8_BAR;
#undef PG8_SA
#undef PG8_SB
#undef PG8_STAGE
#undef PG8_LDA
#undef PG8_LDB
#undef PG8_MMA
#undef PG8_WAIT_V
#undef PG8_WAIT_L
#undef PG8_BAR
#undef PG8_SCHED
}

#define EPI_ARGS const f32x4 (&acc)[2][2][4][2], const Unit& u, int wr, int wc, int fr, int fq
struct G1a {
    static constexpr int K = 1024; static constexpr size_t HSA = 128 * 2048, HSB = 128 * 2048;
    const char* HB; const char* W; bf16_t* UH; bf16_t* SG;
    __device__ __forceinline__ unsigned offA(int R) const { return (unsigned)R * 2048u; }
    __device__ __forceinline__ unsigned offB(int R) const { return (unsigned)R * 2048u; }
    __device__ __forceinline__ void unit(int j, Unit& u) const { tile_of(j, 48, 10, u.pm, u.pn); u.A = HB + (size_t)u.pm * 256 * 2048; u.B = W + (size_t)u.pn * 256 * 2048; }
    __device__ __forceinline__ void epi(EPI_ARGS) const {
#pragma unroll
        for (int ai = 0; ai < 2; ++ai)
#pragma unroll
            for (int m = 0; m < 4; ++m) { const int t = u.pm * 256 + 128 * ai + 64 * wr + 16 * m + fr;
#pragma unroll
                for (int bj = 0; bj < 2; ++bj) { const int col = u.pn * 256 + 128 * bj + 32 * wc + 8 * fq; const f32x4 a = acc[ai][bj][m][0], b = acc[ai][bj][m][1];
                    if (u.pn < 2) { const int gg = col >> 4, h0 = col & 15; st16(UH + ((size_t)(gg * NCH + (t >> 4)) * 512 + (t & 15) * 16 + h0), pack8(a, b)); }
                    else { f32x4 sa, sb;
#pragma unroll
                        for (int q = 0; q < 4; ++q) { sa[q] = sigm(a[q]); sb[q] = sigm(b[q]); }
                        st16(SG + ((size_t)t * 2048 + (col - 512)), pack8(sa, sb)); } } }
    }
};
struct G1b {
    static constexpr int K = 1024; static constexpr size_t HSA = 128 * 2048, HSB = 2 * 2048;
    const char* HB; const char* W; bf16_t* XS;
    __device__ __forceinline__ unsigned offA(int R) const { return (unsigned)R * 2048u; }
    __device__ __forceinline__ unsigned offB(int R) const { return (unsigned)(64 * (R & 63) + (R >> 6)) * 2048u; }
    __device__ __forceinline__ void unit(int j, Unit& u) const { tile_of(j, 4, 32, u.pm, u.pn); u.A = W + (size_t)u.pm * 256 * 2048; const int s = u.pn >> 4, a0 = 4 * (u.pn & 15); u.B = HB + (size_t)(NTP + 4096 * s + a0) * 2048; }
    __device__ __forceinline__ void epi(EPI_ARGS) const {
        const int s = u.pn >> 4, a0 = 4 * (u.pn & 15);
#pragma unroll
        for (int ai = 0; ai < 2; ++ai)
#pragma unroll
            for (int m = 0; m < 4; ++m) { const int q = 64 * wr + 16 * m + fr, gq = u.pm * 128 + q;
#pragma unroll
                for (int bj = 0; bj < 2; ++bj) { const int la = a0 + 2 * bj + (wc >> 1), lb0 = 32 * (wc & 1) + 8 * fq;
                    const size_t idx = ((((size_t)((gq >> 1) * 2 + s) * 64 + la) * 2 + (gq & 1)) * 2 + ai) * 64 + lb0;
                    st16(XS + idx, pack8(acc[ai][bj][m][0], acc[ai][bj][m][1])); } }
    }
};
struct G1c {
    static constexpr int K = 1024; static constexpr size_t HSA = 128 * 2048, HSB = 128 * 2048;
    const char* HB; const char* W; bf16_t* XP;
    __device__ __forceinline__ unsigned offA(int R) const { return (unsigned)R * 2048u; }
    __device__ __forceinline__ unsigned offB(int R) const { return (unsigned)R * 2048u; }
    __device__ __forceinline__ void unit(int j, Unit& u) const { tile_of(j, 4, 16, u.pm, u.pn); u.A = W + (size_t)u.pm * 256 * 2048; u.B = HB + (size_t)(256 * u.pn) * 2048; }
    __device__ __forceinline__ void epi(EPI_ARGS) const {
#pragma unroll
        for (int ai = 0; ai < 2; ++ai)
#pragma unroll
            for (int m = 0; m < 4; ++m) { const int q = 64 * wr + 16 * m + fr, gq = u.pm * 128 + q;
#pragma unroll
                for (int bj = 0; bj < 2; ++bj) { const int l0 = 128 * bj + 32 * wc + 8 * fq;
                    const size_t idx = ((size_t)(u.pn * 512 + gq) * 2 + ai) * 256 + l0;
                    st16(XP + idx, pack8(acc[ai][bj][m][0], acc[ai][bj][m][1])); } }
    }
};
struct Gglu {
    static constexpr int K = 512; static constexpr size_t HSA = 128 * 1024, HSB = 128 * 1024;
    const char* ZB; const char* W; const float* bias; bf16_t* YS;
    __device__ __forceinline__ unsigned offA(int R) const { return (unsigned)R * 1024u; }
    __device__ __forceinline__ unsigned offB(int R) const { return (unsigned)R * 1024u; }
    __device__ __forceinline__ void unit(int j, Unit& u) const { tile_of(j, 48, 2, u.pm, u.pn); u.A = ZB + (size_t)u.pm * 256 * 1024; u.B = W + (size_t)u.pn * 256 * 1024; }
    __device__ __forceinline__ void epi(EPI_ARGS) const {
#pragma unroll
        for (int bj = 0; bj < 2; ++bj) { const int col = u.pn * 256 + 128 * bj + 32 * wc + 8 * fq;
            const f32x4 b0 = *(const f32x4*)(bias + col), b1 = *(const f32x4*)(bias + col + 4);
#pragma unroll
            for (int ai = 0; ai < 2; ++ai)
#pragma unroll
                for (int m = 0; m < 4; ++m) { const int t = u.pm * 256 + 128 * ai + 64 * wr + 16 * m + fr;
                    f32x4 z0, z1; unpack8(*(const u32x4*)((const bf16_t*)ZB + (size_t)t * 512 + col), z0, z1);
                    f32x4 a = acc[ai][bj][m][0] + b0, b = acc[ai][bj][m][1] + b1;
#pragma unroll
                    for (int q = 0; q < 4; ++q) { a[q] = z0[q] * sigm(a[q]); b[q] = z1[q] * sigm(b[q]); }
                    st16(YS + (size_t)t * 512 + col, pack8(a, b)); asm volatile("" ::: "memory"); } }
    }
};
struct Gps {
    static constexpr int K = 512; static constexpr size_t HSA = 128 * 1024, HSB = 128 * 1024;
    const char* A; const char* W; const bf16_t* SG; float* T1;
    __device__ __forceinline__ unsigned offA(int R) const { return (unsigned)R * 1024u; }
    __device__ __forceinline__ unsigned offB(int R) const { return (unsigned)R * 1024u; }
    __device__ __forceinline__ void unit(int j, Unit& u) const { tile_of(j, 48, 4, u.pm, u.pn); u.A = A + (size_t)u.pm * 256 * 1024; u.B = W + (size_t)u.pn * 256 * 1024; }
    __device__ __forceinline__ void epi(EPI_ARGS) const {
#pragma unroll
        for (int ai = 0; ai < 2; ++ai)
#pragma unroll
            for (int m = 0; m < 4; ++m) { const int t = u.pm * 256 + 128 * ai + 64 * wr + 16 * m + fr;
#pragma unroll
                for (int bj = 0; bj < 2; ++bj) { const int col = u.pn * 256 + 128 * bj + 32 * wc + 8 * fq;
                    f32x4 s0, s1; unpack8(*(const u32x4*)(SG + (size_t)t * 2048 + col), s0, s1);
                    st16f(T1 + (size_t)t * 1024 + col, s0 * acc[ai][bj][m][0]); st16f(T1 + (size_t)t * 1024 + col + 4, s1 * acc[ai][bj][m][1]); } asm volatile("" ::: "memory"); }
    }
};
struct Gpf {
    static constexpr int K = 512; static constexpr size_t HSA = 128 * 1024, HSB = 128 * 1024;
    const char* A; const char* W; const bf16_t* SG; const float* T1; bf16_t* MB;
    __device__ __forceinline__ unsigned offA(int R) const { return (unsigned)R * 1024u; }
    __device__ __forceinline__ unsigned offB(int R) const { return (unsigned)R * 1024u; }
    __device__ __forceinline__ void unit(int j, Unit& u) const { tile_of(j, 48, 4, u.pm, u.pn); u.A = A + (size_t)u.pm * 256 * 1024; u.B = W + (size_t)u.pn * 256 * 1024; }
    __device__ __forceinline__ void epi(EPI_ARGS) const {
#pragma unroll
        for (int ai = 0; ai < 2; ++ai)
#pragma unroll
            for (int m = 0; m < 4; ++m) { const int t = u.pm * 256 + 128 * ai + 64 * wr + 16 * m + fr;
#pragma unroll
                for (int bj = 0; bj < 2; ++bj) { const int col = u.pn * 256 + 128 * bj + 32 * wc + 8 * fq;
                    f32x4 s0, s1; unpack8(*(const u32x4*)(SG + (size_t)t * 2048 + 1024 + col), s0, s1);
                    const f32x4 t0 = *(const f32x4*)(T1 + (size_t)t * 1024 + col), t1 = *(const f32x4*)(T1 + (size_t)t * 1024 + col + 4);
                    st16(MB + (size_t)t * 1024 + col, pack8(t0 + s0 * acc[ai][bj][m][0], t1 + s1 * acc[ai][bj][m][1])); } asm volatile("" ::: "memory"); }
    }
};
struct Gwo {
    static constexpr int K = 1024; static constexpr size_t HSA = 128 * 2048, HSB = 128 * 2048;
    const char* A; const char* W; const float* xp; const float* xs; const float* MOD; const float* g2; float* X1; bf16_t* A2B; float* SSQ;
    __device__ __forceinline__ unsigned offA(int R) const { return (unsigned)R * 2048u; }
    __device__ __forceinline__ unsigned offB(int R) const { return (unsigned)R * 2048u; }
    __device__ __forceinline__ void unit(int j, Unit& u) const { tile_of(j, 48, 4, u.pm, u.pn); u.A = A + (size_t)u.pm * 256 * 2048; u.B = W + (size_t)u.pn * 256 * 2048; }
    __device__ __forceinline__ void epi(EPI_ARGS) const {
        const int mi = u.pm < 16 ? 0 : (u.pm < 32 ? 1 : 2);
        const float* xin = u.pm < 16 ? xp + (size_t)u.pm * 256 * 1024 : xs + (size_t)(u.pm - 16) * 256 * 1024;
        const float* md = MOD + mi * 6144;
        float ss[2][4];
#pragma unroll
        for (int ai = 0; ai < 2; ++ai)
#pragma unroll
            for (int m = 0; m < 4; ++m) ss[ai][m] = 0.f;
#pragma unroll
        for (int bj = 0; bj < 2; ++bj) { const int col = u.pn * 256 + 128 * bj + 32 * wc + 8 * fq;
            const f32x4 ga = *(const f32x4*)(md + 2048 + col), gb = *(const f32x4*)(md + 2048 + col + 4);
            const f32x4 sa = (*(const f32x4*)(md + 4096 + col) + 1.0f) * *(const f32x4*)(g2 + col), sb = (*(const f32x4*)(md + 4096 + col + 4) + 1.0f) * *(const f32x4*)(g2 + col + 4);
#pragma unroll
            for (int ai = 0; ai < 2; ++ai)
#pragma unroll
                for (int m = 0; m < 4; ++m) { const int rl = 128 * ai + 64 * wr + 16 * m + fr; const size_t t = (size_t)u.pm * 256 + rl;
                    const f32x4 x0 = *(const f32x4*)(xin + (size_t)rl * 1024 + col) + ga * acc[ai][bj][m][0], x1 = *(const f32x4*)(xin + (size_t)rl * 1024 + col + 4) + gb * acc[ai][bj][m][1];
                    st16f(X1 + t * 1024 + col, x0); st16f(X1 + t * 1024 + col + 4, x1);
                    st16(A2B + t * 1024 + col, pack8(x0 * sa, x1 * sb));
                    ss[ai][m] += (x0[0] * x0[0] + x0[1] * x0[1]) + (x0[2] * x0[2] + x0[3] * x0[3]) + (x1[0] * x1[0] + x1[1] * x1[1]) + (x1[2] * x1[2] + x1[3] * x1[3]);
                    asm volatile("" ::: "memory"); } }
#pragma unroll
        for (int ai = 0; ai < 2; ++ai)
#pragma unroll
            for (int m = 0; m < 4; ++m) { float s = ss[ai][m]; s += __shfl_xor(s, 16); s += __shfl_xor(s, 32);
                if (fq == 0) st4f(SSQ + ((size_t)u.pm * 256 + 128 * ai + 64 * wr + 16 * m + fr) * 16 + u.pn * 4 + wc, s); }
    }
};
struct Ggu {
    static constexpr int K = 1024; static constexpr size_t HSA = 128 * 2048, HSB = 128 * 2048;
    const char* A; const char* W; const float* SSQ; const float* SV; bf16_t* FF;
    __device__ __forceinline__ unsigned offA(int R) const { return (unsigned)R * 2048u; }
    __device__ __forceinline__ unsigned offB(int R) const { return (unsigned)R * 2048u; }
    __device__ __forceinline__ void unit(int j, Unit& u) const { tile_of(j, 48, 22, u.pm, u.pn); u.A = A + (size_t)u.pm * 256 * 2048; u.B = W + (size_t)u.pn * 256 * 2048; }
    __device__ __forceinline__ void epi(EPI_ARGS) const {
        const int mi = u.pm < 16 ? 0 : (u.pm < 32 ? 1 : 2);
        const float* sv = SV + mi * 5632 + u.pn * 256 + 32 * wc + 8 * fq;
        const f32x4 g0 = *(const f32x4*)(sv), g1 = *(const f32x4*)(sv + 4), u0 = *(const f32x4*)(sv + 128), u1 = *(const f32x4*)(sv + 132);
        const int col = u.pn * 128 + 32 * wc + 8 * fq;
#pragma unroll
        for (int ai = 0; ai < 2; ++ai)
#pragma unroll
            for (int m = 0; m < 4; ++m) { const size_t t = (size_t)u.pm * 256 + 128 * ai + 64 * wr + 16 * m + fr;
                const f32x4* sp = (const f32x4*)(SSQ + t * 16); const f32x4 q4 = (sp[0] + sp[1]) + (sp[2] + sp[3]);
                const float r = __builtin_amdgcn_rsqf(((q4[0] + q4[1]) + (q4[2] + q4[3])) * (1.0f / 1024.0f) + EPS);
                f32x4 ga = acc[ai][0][m][0] * r + g0, gb = acc[ai][0][m][1] * r + g1; const f32x4 ua = acc[ai][1][m][0] * r + u0, ub = acc[ai][1][m][1] * r + u1;
#pragma unroll
                for (int q = 0; q < 4; ++q) { ga[q] = ga[q] * sigm(ga[q]) * ua[q]; gb[q] = gb[q] * sigm(gb[q]) * ub[q]; }
                st16(FF + t * DFF + col, pack8(ga, gb)); asm volatile("" ::: "memory"); }
    }
};
struct Gdn {
    static constexpr int K = 2816; static constexpr size_t HSA = 128 * 5632, HSB = 128 * 5632;
    const char* A; const char* W; const float* X1; const float* MOD; float* OUT; float* SSQ;
    __device__ __forceinline__ unsigned offA(int R) const { return (unsigned)R * 5632u; }
    __device__ __forceinline__ unsigned offB(int R) const { return (unsigned)R * 5632u; }
    __device__ __forceinline__ void unit(int j, Unit& u) const { tile_of(j, 48, 4, u.pm, u.pn); u.A = A + (size_t)u.pm * 256 * 5632; u.B = W + (size_t)u.pn * 256 * 5632; }
    __device__ __forceinline__ void epi(EPI_ARGS) const {
        const int mi = u.pm < 16 ? 0 : (u.pm < 32 ? 1 : 2);
        const float* md = MOD + mi * 6144 + 5 * 1024;
        float ss[2][4];
#pragma unroll
        for (int ai = 0; ai < 2; ++ai)
#pragma unroll
            for (int m = 0; m < 4; ++m) ss[ai][m] = 0.f;
#pragma unroll
        for (int bj = 0; bj < 2; ++bj) { const int col = u.pn * 256 + 128 * bj + 32 * wc + 8 * fq;
            const f32x4 ga = *(const f32x4*)(md + col), gb = *(const f32x4*)(md + col + 4);
#pragma unroll
            for (int ai = 0; ai < 2; ++ai)
#pragma unroll
                for (int m = 0; m < 4; ++m) { const size_t t = (size_t)u.pm * 256 + 128 * ai + 64 * wr + 16 * m + fr;
                    const f32x4 x0 = *(const f32x4*)(X1 + t * 1024 + col) + ga * acc[ai][bj][m][0], x1 = *(const f32x4*)(X1 + t * 1024 + col + 4) + gb * acc[ai][bj][m][1];
                    st16f(OUT + t * 1024 + col, x0); st16f(OUT + t * 1024 + col + 4, x1);
                    ss[ai][m] += (x0[0] * x0[0] + x0[1] * x0[1]) + (x0[2] * x0[2] + x0[3] * x0[3]) + (x1[0] * x1[0] + x1[1] * x1[1]) + (x1[2] * x1[2] + x1[3] * x1[3]);
                    asm volatile("" ::: "memory"); } }
#pragma unroll
        for (int ai = 0; ai < 2; ++ai)
#pragma unroll
            for (int m = 0; m < 4; ++m) { float s = ss[ai][m]; s += __shfl_xor(s, 16); s += __shfl_xor(s, 32);
                if (fq == 0) st4f(SSQ + ((size_t)u.pm * 256 + 128 * ai + 64 * wr + 16 * m + fr) * 16 + u.pn * 4 + wc, s); }
    }
};

struct GF2 {
    static constexpr int K = 256; static constexpr size_t HSA = 128 * 512, HSB = 128 * 512;
    const char* D1; const char* XS; const float* TW; bf16_t* Y1;
    __device__ __forceinline__ unsigned offA(int R) const { return (unsigned)R * 512u; }
    __device__ __forceinline__ unsigned offB(int R) const { return (unsigned)R * 512u; }
    __device__ __forceinline__ void unit(int j, Unit& u) const { u.pm = 0; u.pn = j; u.A = D1; u.B = XS + (size_t)j * 256 * 512; }
    __device__ __forceinline__ void epi(EPI_ARGS) const {
        const float* tw = TW; int fr2 = fr; asm volatile("" : "+s"(tw), "+v"(fr2));
#pragma unroll
        for (int bj = 0; bj < 2; ++bj) { const int combo = 4 * u.pn + 2 * bj + (wc >> 1), s = combo & 1, gq = 2 * (combo >> 1) + wr, la0 = 32 * (wc & 1) + 8 * fq;
#pragma unroll
            for (int m = 0; m < 4; ++m) { const int kb = 16 * m + fr2;
                const f32x4* tp = (const f32x4*)(tw + (size_t)(kb * 64 + la0) * 2);
                const f32x4 t0 = tp[0], t1 = tp[1], t2 = tp[2], t3 = tp[3];
                const f32x4 r0 = acc[0][bj][m][0], r1 = acc[0][bj][m][1], i0 = acc[1][bj][m][0], i1 = acc[1][bj][m][1];
                f32x4 pr0, pr1, pi0, pi1;
                pr0[0] = r0[0] * t0[0] + i0[0] * t0[1]; pi0[0] = i0[0] * t0[0] - r0[0] * t0[1];
                pr0[1] = r0[1] * t0[2] + i0[1] * t0[3]; pi0[1] = i0[1] * t0[2] - r0[1] * t0[3];
                pr0[2] = r0[2] * t1[0] + i0[2] * t1[1]; pi0[2] = i0[2] * t1[0] - r0[2] * t1[1];
                pr0[3] = r0[3] * t1[2] + i0[3] * t1[3]; pi0[3] = i0[3] * t1[2] - r0[3] * t1[3];
                pr1[0] = r1[0] * t2[0] + i1[0] * t2[1]; pi1[0] = i1[0] * t2[0] - r1[0] * t2[1];
                pr1[1] = r1[1] * t2[2] + i1[1] * t2[3]; pi1[1] = i1[1] * t2[2] - r1[1] * t2[3];
                pr1[2] = r1[2] * t3[0] + i1[2] * t3[1]; pi1[2] = i1[2] * t3[0] - r1[2] * t3[1];
                pr1[3] = r1[3] * t3[2] + i1[3] * t3[3]; pi1[3] = i1[3] * t3[2] - r1[3] * t3[3];
                const size_t base = ((((size_t)(s * 512 + gq) * 16 + (kb >> 2)) * 4 + (kb & 3)) * 2) * 64 + la0;
                st16(Y1 + base, pack8(pr0, pr1)); st16(Y1 + base + 64, pack8(pi0, pi1)); asm volatile("" ::: "memory"); } }
    }
};
struct GSA {
    static constexpr int K = 256; static constexpr size_t HSA = 128 * 1024, HSB = 128 * 512;
    const char* UH; const char* SF; float* SST;
    __device__ __forceinline__ unsigned offA(int R) const { return (unsigned)R * 1024u; }
    __device__ __forceinline__ unsigned offB(int R) const { return (unsigned)R * 512u; }
    __device__ __forceinline__ void unit(int j, Unit& u) const { u.pn = j / 3; u.pm = j - 3 * u.pn; u.A = UH + (size_t)(u.pn * NCH + 256 * u.pm) * 1024; u.B = SF + (size_t)u.pn * 256 * 512; }
    __device__ __forceinline__ void epi(EPI_ARGS) const {
#pragma unroll
        for (int ai = 0; ai < 2; ++ai)
#pragma unroll
            for (int m = 0; m < 4; ++m) { const int chunk = 256 * u.pm + 128 * ai + 64 * wr + 16 * m + fr;
#pragma unroll
                for (int bj = 0; bj < 2; ++bj) { float* d = SST + (size_t)(u.pn * NCH + chunk) * 256 + 128 * bj + 32 * wc + 8 * fq;
                    st16f(d, acc[ai][bj][m][0]); st16f(d + 4, acc[ai][bj][m][1]); } }
    }
};
struct GF3s {
    static constexpr int K = 512; static constexpr size_t HSA = 128 * 1024, HSB = 8 * 1024;
    const char* D2; const char* Y1; bf16_t* YF;
    __device__ __forceinline__ unsigned offA(int R) const { return (unsigned)R * 1024u; }
    __device__ __forceinline__ unsigned offB(int R) const { return (unsigned)((R & 15) * 16 + (R >> 4)) * 1024u; }
    __device__ __forceinline__ void unit(int j, Unit& u) const { u.pm = j >> 5; u.pn = 16 * (j & 31); u.A = D2; u.B = Y1 + (size_t)((u.pm * 512 + u.pn) * 16) * 1024; }
    __device__ __forceinline__ void epi(EPI_ARGS) const {
#pragma unroll
        for (int ai = 0; ai < 2; ++ai)
#pragma unroll
            for (int m = 0; m < 4; ++m) { const int mu2 = 2 * ai + wr, ka = 16 * m + fr;
#pragma unroll
                for (int bj = 0; bj < 2; ++bj) { const int c0 = 128 * bj + 32 * wc + 8 * fq, kap = c0 >> 4, qi0 = c0 & 15;
                    const int k = 64 * ka + 4 * kap + mu2;
                    st16(YF + (size_t)(NTP + 4096 * u.pm + k) * 512 + u.pn + qi0, pack8(acc[ai][bj][m][0], acc[ai][bj][m][1])); } }
    }
};
struct GF3p {
    static constexpr int K = 512; static constexpr size_t HSA = 128 * 1024, HSB = 128 * 1024;
    const char* DP; const char* XP; bf16_t* YF;
    __device__ __forceinline__ unsigned offA(int R) const { return (unsigned)R * 1024u; }
    __device__ __forceinline__ unsigned offB(int R) const { return (unsigned)R * 1024u; }
    __device__ __forceinline__ void unit(int j, Unit& u) const { u.pm = 0; u.pn = j; u.A = DP; u.B = XP + (size_t)j * 256 * 1024; }
    __device__ __forceinline__ void epi(EPI_ARGS) const {
#pragma unroll
        for (int ai = 0; ai < 2; ++ai)
#pragma unroll
            for (int m = 0; m < 4; ++m) { const int k = 128 * ai + 64 * wr + 16 * m + fr;
#pragma unroll
                for (int bj = 0; bj < 2; ++bj) { const int xr = 256 * u.pn + 128 * bj + 32 * wc + 8 * fq, b = xr >> 9, gq = xr & 511;
                    st16(YF + (size_t)(256 * b + k) * 512 + gq, pack8(acc[ai][bj][m][0], acc[ai][bj][m][1])); } }
    }
};
struct GSC {
    static constexpr int K = 512; static constexpr size_t HSA = 128 * 1024, HSB = 128 * 1024;
    const char* UH; const char* ME; bf16_t* ZB;
    __device__ __forceinline__ unsigned offA(int R) const { return (unsigned)R * 1024u; }
    __device__ __forceinline__ unsigned offB(int R) const { return (unsigned)R * 1024u; }
    __device__ __forceinline__ void unit(int j, Unit& u) const { u.pn = j / 3; u.pm = j - 3 * u.pn; u.A = UH + (size_t)(u.pn * NCH + 256 * u.pm) * 1024; u.B = ME + (size_t)u.pn * 256 * 1024; }
    __device__ __forceinline__ void epi(EPI_ARGS) const {
#pragma unroll
        for (int ai = 0; ai < 2; ++ai)
#pragma unroll
            for (int m = 0; m < 4; ++m) { const int chunk = 256 * u.pm + 128 * ai + 64 * wr + 16 * m + fr;
#pragma unroll
                for (int bj = 0; bj < 2; ++bj) { const int c0 = 128 * bj + 32 * wc + 8 * fq, i = c0 >> 4, h0 = c0 & 15;
                    f32x4 a = acc[ai][bj][m][0], b = acc[ai][bj][m][1];
#pragma unroll
                    for (int q = 0; q < 4; ++q) { a[q] = gelu_tanh(a[q]); b[q] = gelu_tanh(b[q]); }
                    st16(ZB + (size_t)(16 * chunk + i) * 512 + 16 * u.pn + h0, pack8(a, b)); } }
    }
};

struct Params {
    const float* in[27];
    float* out;
    unsigned char* wsp;
};

__device__ __forceinline__ void transpose_item(const float* W, int ldw, int n0, int k0, bf16_t* WT, int drow, int Kd, LAS float* scr, int lane) {
#pragma unroll 8
    for (int i = 0; i < 32; ++i) { const int kk = 2 * i + (lane >> 5); scr[kk * 33 + (lane & 31)] = W[(size_t)(k0 + kk) * ldw + n0 + (lane & 31)]; }
    asm volatile("s_waitcnt lgkmcnt(0)" ::: "memory");
    const int c = lane & 7;
#pragma unroll
    for (int jj = 0; jj < 4; ++jj) { const int n = (lane >> 3) + 8 * jj; const LAS float* s = scr + (8 * c) * 33 + n;
        u32x4 o; o.x = cvt_pk_bf16(s[0 * 33], s[1 * 33]); o.y = cvt_pk_bf16(s[2 * 33], s[3 * 33]); o.z = cvt_pk_bf16(s[4 * 33], s[5 * 33]); o.w = cvt_pk_bf16(s[6 * 33], s[7 * 33]);
        st16(WT + (size_t)(drow + n) * Kd + k0 + 8 * c, o); }
    asm volatile("s_waitcnt lgkmcnt(0)" ::: "memory");
}

__global__ void __launch_bounds__(512, 2) fwd_kernel(Params P) {
    extern __shared__ __attribute__((aligned(16))) unsigned char lds_raw[];
    LAS unsigned char* lds = (LAS unsigned char*)lds_raw;
    cg::grid_group grid = cg::this_grid();
#define GRID_SYNC() do { asm volatile("s_waitcnt vmcnt(0) lgkmcnt(0)" ::: "memory"); grid.sync(); if (threadIdx.x < 64) { __builtin_amdgcn_fence(__ATOMIC_ACQUIRE, "agent"); asm volatile("s_waitcnt vmcnt(0)" ::: "memory"); } __syncthreads(); } while (0)
#define FRESH_IDS int tid = threadIdx.x; asm volatile("" : "+v"(tid)); const int lane = tid & 63, wave = __builtin_amdgcn_readfirstlane(tid >> 6); \
    const int gw = blockIdx.x * 8 + wave, NGW = gridDim.x * 8; (void)lane; (void)gw; (void)NGW;
#define ws (P.wsp)
#define x_prompt (P.in[0])
#define x_sample (P.in[1])
#define state_s5 (P.in[2])
#define cvec (P.in[3])
#define c_ctx (P.in[4])
#define norm1_g (P.in[5])
#define norm2_g (P.in[6])
#define w_ada (P.in[7])
#define b_ada (P.in[8])
#define w_in (P.in[9])
#define lam_re (P.in[10])
#define lam_im (P.in[11])
#define log_step (P.in[12])
#define b_re (P.in[13])
#define b_im (P.in[14])
#define c_re (P.in[15])
#define c_im (P.in[16])
#define s5_d (P.in[17])
#define w_glu (P.in[18])
#define b_glu (P.in[19])
#define w_ps (P.in[20])
#define w_pf (P.in[21])
#define w_o (P.in[22])
#define w_g (P.in[23])
#define w_u (P.in[24])
#define w_d (P.in[25])
#define fin_g (P.in[26])
#define CTL ((unsigned*)(ws + WS_CTL))
#define MOD ((float*)(ws + WS_MOD))
#define SVGU ((float*)(ws + WS_SVGU))
#define MODP ((float*)(ws + WS_MODP))
#define SSQ2 ((float*)(ws + WS_SSQ2))
#define SSQ3 ((float*)(ws + WS_SSQ3))
#define W1T ((bf16_t*)(ws + WS_W1T))
#define WFT ((bf16_t*)(ws + WS_WFT))
#define WGLU ((bf16_t*)(ws + WS_WGLU))
#define WPS ((bf16_t*)(ws + WS_WPS))
#define WPF ((bf16_t*)(ws + WS_WPF))
#define WO ((bf16_t*)(ws + WS_WO))
#define WGU ((bf16_t*)(ws + WS_WGU))
#define WD ((bf16_t*)(ws + WS_WD))
#define SG ((bf16_t*)(ws + WS_R1))
#define X1 ((float*)(ws + WS_R1))
#define UH ((bf16_t*)(ws + WS_R3))
#define A2B ((bf16_t*)(ws + WS_R3))
#define T1 ((float*)(ws + WS_R3))
#define XS ((bf16_t*)(ws + WS_R4))
#define XP ((bf16_t*)(ws + WS_XP))
#define FF ((bf16_t*)(ws + WS_R4))
#define ZB ((bf16_t*)(ws + WS_R5))
#define YS ((bf16_t*)(ws + WS_YS))
#define YF ((bf16_t*)(ws + WS_YF))
#define HB ((bf16_t*)(ws + WS_R2))
#define YACC ((float*)(ws + WS_R2))
#define MB ((bf16_t*)(ws + WS_R2))
#define SST ((float*)(ws + WS_R2))
#define Y1B ((bf16_t*)(ws + WS_R5))
#define SFM ((bf16_t*)(ws + WS_SF))
#define MEM ((bf16_t*)(ws + WS_ME))
#define KKM ((float*)(ws + WS_KK))
#define A16M ((float*)(ws + WS_A16))
#define D1M ((bf16_t*)(ws + WS_D1))
#define D2M ((bf16_t*)(ws + WS_D2))
#define DPM ((bf16_t*)(ws + WS_DP))
#define TWM ((float*)(ws + WS_TW))
#define OUT (P.out)

    {
        FRESH_IDS
        if (blockIdx.x < 128) {
            LAS float* tile = (LAS float*)lds;
            LAS float* cs = tile + 32 * 132; LAS float* sn = cs + 128;
            const int gg = blockIdx.x >> 5, k0 = 32 * (blockIdx.x & 31);
            for (int idx = tid; idx < 32 * 32; idx += 512) { const int row = idx >> 5, c4 = idx & 31;
                const f32x4 v = *(const f32x4*)(w_in + (size_t)(k0 + row) * 3072 + 512 + 128 * gg + 4 * c4);
                *(LAS f32x4*)(tile + row * 132 + 4 * c4) = v; }
            if (tid < 128) { float s, c; sincos_frac(tid, 128, s, c); cs[tid] = c * 0.08838834764831845f; sn[tid] = s * 0.08838834764831845f; }
            __syncthreads();
            const int n = tid & 255, part = n >> 7, q = n & 127, kh = tid >> 8;
            float a[16];
#pragma unroll
            for (int i = 0; i < 16; ++i) a[i] = 0.f;
            const LAS float* tb = part ? sn : cs;
            for (int c = 0; c < 128; c += 4) {
                const float r0 = tb[(q * c) & 127], r1 = tb[(q * (c + 1)) & 127], r2 = tb[(q * (c + 2)) & 127], r3 = tb[(q * (c + 3)) & 127];
#pragma unroll
                for (int i = 0; i < 16; ++i) { const f32x4 w = *(const LAS f32x4*)(tile + (16 * kh + i) * 132 + c); a[i] += (w[0] * r0 + w[1] * r1) + (w[2] * r2 + w[3] * r3); }
            }
            bf16_t* dst = WFT + (size_t)(gg * 256 + n) * 1024 + k0 + 16 * kh;
            u32x4 o0, o1; o0.x = cvt_pk_bf16(a[0], a[1]); o0.y = cvt_pk_bf16(a[2], a[3]); o0.z = cvt_pk_bf16(a[4], a[5]); o0.w = cvt_pk_bf16(a[6], a[7]);
            o1.x = cvt_pk_bf16(a[8], a[9]); o1.y = cvt_pk_bf16(a[10], a[11]); o1.z = cvt_pk_bf16(a[12], a[13]); o1.w = cvt_pk_bf16(a[14], a[15]);
            st16(dst, o0); st16(dst + 8, o1);
            __syncthreads();
        }
        else if (blockIdx.x < 192) {
            LAS float* Wre = (LAS float*)lds; LAS float* Wim = Wre + 16384;
            LAS float* Cre = Wim + 16384; LAS float* Cim = Cre + 16 * 65;
            const int td = blockIdx.x - 128, gg = td >> 1, d = td & 1;
            {
                const int p = tid & 63, hq = tid >> 6, pi = (d * 32 + gg) * 64 + p;
                const float lr = lam_re[pi], li = lam_im[pi], step = __expf(log_step[d * 32 + gg]);
                double sd, cd; sincos_d((double)(li * step), sd, cd);
                const float mag = __expf(lr * step), are = mag * (float)cd, aim = mag * (float)sd;
                const float nr = are - 1.0f, ni = aim, den = lr * lr + li * li, fr_ = (nr * lr + ni * li) / den, fi_ = (ni * lr - nr * li) / den;
                float wr_[2], wi_[2], cr_[2], ci_[2];
#pragma unroll
                for (int e = 0; e < 2; ++e) { const int h = 2 * hq + e; const float br = b_re[(size_t)pi * 16 + h], bi = b_im[(size_t)pi * 16 + h];
                    wr_[e] = fr_ * br - fi_ * bi; wi_[e] = fr_ * bi + fi_ * br;
                    cr_[e] = c_re[((size_t)(d * 32 + gg) * 16 + h) * 64 + p]; ci_[e] = c_im[((size_t)(d * 32 + gg) * 16 + h) * 64 + p];
                    Cre[h * 65 + p] = cr_[e]; Cim[h * 65 + p] = ci_[e]; }
                float pr = are, pim = aim;
#pragma unroll
                for (int m = 0; m < 16; ++m) {
#pragma unroll
                    for (int e = 0; e < 2; ++e) { const int h = 2 * hq + e; Wre[(m * 64 + p) * 16 + h] = wr_[e]; Wim[(m * 64 + p) * 16 + h] = wi_[e];
                        const float nwr = are * wr_[e] - aim * wi_[e], nwi = are * wi_[e] + aim * wr_[e]; wr_[e] = nwr; wi_[e] = nwi;
                        const float vr = cr_[e] * pr - ci_[e] * pim, vi = cr_[e] * pim + ci_[e] * pr;
                        const int irow = d ? 15 - m : m;
                        float* dst = (float*)(MEM + ((size_t)(gg * 256 + 16 * irow + h) * 512 + 256 + d * 128 + 2 * p));
                        st4f(dst, __uint_as_float(cvt_pk_bf16(vr, -vi))); }
                    if (m == 15 && hq == 0) { float* a16 = A16M + (size_t)((gg * 2 + d) * 64 + p) * 2; st4f(a16, pr); st4f(a16 + 1, pim); }
                    const float npr = pr * are - pim * aim, npi = pr * aim + pim * are; pr = npr; pim = npi;
                }
            }
            __syncthreads();
            {
                const int nl = tid >> 2, p = nl >> 1, ri = nl & 1, qt = tid & 3;
                const LAS float* Wsrc = ri ? Wim : Wre;
#pragma unroll
                for (int e = 0; e < 4; ++e) { const int jj = 4 * qt + e, m = d ? jj : 15 - jj;
                    const LAS f32x4* wp = (const LAS f32x4*)(Wsrc + (m * 64 + p) * 16);
                    bf16_t* dst = SFM + ((size_t)(gg * 256 + d * 128 + nl) * 256 + 16 * jj);
                    st16(dst, pack8(wp[0], wp[1])); st16(dst + 8, pack8(wp[2], wp[3])); }
            }
            {
                const int m = tid >> 5, hp = (tid >> 1) & 15, hh = (tid & 1) * 8;
                f32x4 a0 = {0.f, 0.f, 0.f, 0.f}, a1 = a0;
                for (int p = 0; p < 64; ++p) { const float cr = Cre[hp * 65 + p], ci = Cim[hp * 65 + p];
                    const LAS f32x4* wrp = (const LAS f32x4*)(Wre + (m * 64 + p) * 16 + hh); const LAS f32x4* wip = (const LAS f32x4*)(Wim + (m * 64 + p) * 16 + hh);
                    a0 += wrp[0] * cr - wip[0] * ci; a1 += wrp[1] * cr - wip[1] * ci; }
                float* dst = KKM + ((size_t)((gg * 2 + d) * 16 + m) * 256 + hp * 16 + hh);
                st16f(dst, a0); st16f(dst + 4, a1);
            }
            __syncthreads();
        }
        else {
            const int gt = (blockIdx.x - 192) * 512 + tid, ngt = (gridDim.x - 192) * 512;
            for (int tk = gt; tk < 8192 + 16384 + 16384 + 2048; tk += ngt) {
                float v[8];
                if (tk < 8192) {
                    const int r = tk >> 5, k0 = (tk & 31) * 8, pp = r >> 7, mup = (r >> 6) & 1, kb = r & 63, mu = k0 >> 7, part = (k0 >> 6) & 1, lb0 = k0 & 63;
#pragma unroll
                    for (int e = 0; e < 8; ++e) { float s, c; sincos_frac(kb * (lb0 + e), 64, s, c);
                        const float val = (pp == 0) ? (part == 0 ? c : -s) : (part == 0 ? -s : -c); v[e] = (mu == mup) ? val * 0.125f : 0.f; }
                    st16(D1M + (size_t)r * 256 + k0, pack8((f32x4){v[0], v[1], v[2], v[3]}, (f32x4){v[4], v[5], v[6], v[7]}));
                } else if (tk < 8192 + 16384) {
                    const int t2 = tk - 8192, r = t2 >> 6, k0 = (t2 & 63) * 8, mu2 = r >> 6, ka = r & 63, mu2p = k0 >> 7, part = (k0 >> 6) & 1, la0 = k0 & 63;
#pragma unroll
                    for (int e = 0; e < 8; ++e) { float s, c; sincos_frac(ka * (la0 + e), 64, s, c); v[e] = (mu2 == mu2p) ? (part == 0 ? c : s) * 0.125f : 0.f; }
                    st16(D2M + (size_t)r * 512 + k0, pack8((f32x4){v[0], v[1], v[2], v[3]}, (f32x4){v[4], v[5], v[6], v[7]}));
                } else if (tk < 8192 + 32768) {
                    const int t2 = tk - 8192 - 16384, r = t2 >> 6, k0 = (t2 & 63) * 8, part = k0 >> 8, l0 = k0 & 255;
#pragma unroll
                    for (int e = 0; e < 8; ++e) { float s, c; sincos_frac(r * (l0 + e), 256, s, c); v[e] = (part == 0 ? c : -s) * 0.0625f; }
                    st16(DPM + (size_t)r * 512 + k0, pack8((f32x4){v[0], v[1], v[2], v[3]}, (f32x4){v[4], v[5], v[6], v[7]}));
                } else {
                    const int t2 = tk - 8192 - 32768, kb = t2 >> 5, la0 = (t2 & 31) * 2;
                    float s0, c0, s1, c1; sincos_frac(kb * la0, 4096, s0, c0); sincos_frac(kb * (la0 + 1), 4096, s1, c1);
                    st16f(TWM + (size_t)(kb * 64 + la0) * 2, (f32x4){c0, s0, c1, s1});
                }
            }
        }
        for (int tk = gw; tk < 768; tk += NGW) {
            const int cgp = tk % 24, kc = tk / 24;
            float sl0 = 0.f, sl1 = 0.f, sl2 = 0.f;
            if (lane < 32) { const int k = kc * 32 + lane; const float a = c_ctx[k], b = cvec[k], c = cvec[1024 + k]; sl0 = a * sigm(a); sl1 = b * sigm(b); sl2 = c * sigm(c); }
            f32x4 a0 = {0.f, 0.f, 0.f, 0.f}, a1 = a0, a2 = a0;
            const float* wp = w_ada + (size_t)(kc * 32) * 6144 + cgp * 256 + lane * 4;
#pragma unroll 8
            for (int kk = 0; kk < 32; ++kk) { const f32x4 w = *(const f32x4*)(wp + (size_t)kk * 6144);
                const float s0 = __shfl(sl0, kk), s1 = __shfl(sl1, kk), s2 = __shfl(sl2, kk);
                a0 += w * s0; a1 += w * s1; a2 += w * s2; }
            float* pp = MODP + (size_t)kc * 3 * 6144 + cgp * 256 + lane * 4;
            st16f(pp, a0); st16f(pp + 6144, a1); st16f(pp + 2 * 6144, a2);
        }
    }
    GRID_SYNC();
    {
        FRESH_IDS
        for (int tk = gw; tk < 24; tk += NGW) {
            const int col = tk * 256 + lane * 4;
            const f32x4 bv = *(const f32x4*)(b_ada + col);
            f32x4 r0 = bv, r1 = bv, r2 = bv;
            for (int k2 = 0; k2 < 32; ++k2) { const float* q = MODP + (size_t)k2 * 3 * 6144 + col;
                r0 += *(const f32x4*)q; r1 += *(const f32x4*)(q + 6144); r2 += *(const f32x4*)(q + 2 * 6144); }
            st16f(MOD + col, r0); st16f(MOD + 6144 + col, r1); st16f(MOD + 2 * 6144 + col, r2);
        }
        LAS float* scr = (LAS float*)(lds + 32768 + wave * 8704);
        for (int it = gw; it < 6656; it += NGW) {
            int r = it;
            if (r < 256) { const int kb = r / 16, nb = r % 16; transpose_item(w_in, 3072, 32 * nb, 64 * kb, W1T, 32 * nb, 1024, scr, lane); continue; } r -= 256;
            if (r < 1024) { const int kb = r / 64, nb = r % 64; transpose_item(w_in, 3072, 1024 + 32 * nb, 64 * kb, W1T, 512 + 32 * nb, 1024, scr, lane); continue; } r -= 1024;
            if (r < 128) { const int kb = r / 16, nb = r % 16; transpose_item(w_glu, 512, 32 * nb, 64 * kb, WGLU, 32 * nb, 512, scr, lane); continue; } r -= 128;
            if (r < 256) { const int kb = r / 32, nb = r % 32; transpose_item(w_ps, 1024, 32 * nb, 64 * kb, WPS, 32 * nb, 512, scr, lane); continue; } r -= 256;
            if (r < 256) { const int kb = r / 32, nb = r % 32; transpose_item(w_pf, 1024, 32 * nb, 64 * kb, WPF, 32 * nb, 512, scr, lane); continue; } r -= 256;
            if (r < 512) { const int kb = r / 32, nb = r % 32; transpose_item(w_o, 1024, 32 * nb, 64 * kb, WO, 32 * nb, 1024, scr, lane); continue; } r -= 512;
            if (r < 1408) { const int kb = r / 88, nb = r % 88, n0 = 32 * nb; transpose_item(w_g, 2816, n0, 64 * kb, WGU, 256 * (n0 >> 7) + (n0 & 127), 1024, scr, lane); continue; } r -= 1408;
            if (r < 1408) { const int kb = r / 88, nb = r % 88, n0 = 32 * nb; transpose_item(w_u, 2816, n0, 64 * kb, WGU, 256 * (n0 >> 7) + 128 + (n0 & 127), 1024, scr, lane); continue; } r -= 1408;
            { const int kb = r / 32, nb = r % 32; transpose_item(w_d, 1024, 32 * nb, 64 * kb, WD, 32 * nb, 2816, scr, lane); }
        }
    }
    GRID_SYNC();
    {
        FRESH_IDS
        for (int t = gw; t < NT; t += NGW) {
            const float* xr = t < NTP ? x_prompt + (size_t)t * 1024 : x_sample + (size_t)(t - NTP) * 1024;
            const int mi = t < NTP ? 0 : (t < NTP + 4096 ? 1 : 2);
            const float* md = MOD + mi * 6144;
            f32x4 v[4]; float s = 0.f;
#pragma unroll
            for (int jx = 0; jx < 4; ++jx) { v[jx] = *(const f32x4*)(xr + 8 * lane + 512 * (jx >> 1) + 4 * (jx & 1)); s += (v[jx][0] * v[jx][0] + v[jx][1] * v[jx][1]) + (v[jx][2] * v[jx][2] + v[jx][3] * v[jx][3]); }
            const float r = 1.0f / sqrtf(wave_sum(s) * (1.0f / 1024.0f) + EPS);
            f32x4 h[4];
#pragma unroll
            for (int jx = 0; jx < 4; ++jx) { const int col = 8 * lane + 512 * (jx >> 1) + 4 * (jx & 1);
                const f32x4 gs = *(const f32x4*)(norm1_g + col) * (*(const f32x4*)(md + 1024 + col) + 1.0f), sh = *(const f32x4*)(md + col);
                h[jx] = v[jx] * r * gs + sh; }
            st16(HB + (size_t)t * 1024 + 8 * lane, pack8(h[0], h[1])); st16(HB + (size_t)t * 1024 + 512 + 8 * lane, pack8(h[2], h[3]));
        }
        for (int idx = blockIdx.x * 512 + tid; idx < 131072; idx += gridDim.x * 512) {
            const int gg = idx >> 12, r = (idx >> 4) & 255, jj = idx & 15, i = r >> 4, hp = r & 15;
            f32x4 v0 = {0.f, 0.f, 0.f, 0.f}, v1 = v0, v2 = v0, v3 = v0;
            if (jj <= i) { const f32x4* kp = (const f32x4*)(KKM + ((size_t)((gg * 2 + 0) * 16 + (i - jj)) * 256 + hp * 16)); v0 += kp[0]; v1 += kp[1]; v2 += kp[2]; v3 += kp[3]; }
            if (jj >= i) { const f32x4* kp = (const f32x4*)(KKM + ((size_t)((gg * 2 + 1) * 16 + (jj - i)) * 256 + hp * 16)); v0 += kp[0]; v1 += kp[1]; v2 += kp[2]; v3 += kp[3]; }
            if (jj == i) { const float dv = s5_d[16 * gg + hp];
#pragma unroll
                for (int e = 0; e < 4; ++e) { v0[e] += (hp == e) ? dv : 0.f; v1[e] += (hp == 4 + e) ? dv : 0.f; v2[e] += (hp == 8 + e) ? dv : 0.f; v3[e] += (hp == 12 + e) ? dv : 0.f; } }
            bf16_t* dst = MEM + ((size_t)(gg * 256 + r) * 512 + 16 * jj);
            st16(dst, pack8(v0, v1)); st16(dst + 8, pack8(v2, v3));
        }
        for (int n = gw; n < 5632; n += NGW) {
            const u32x4 w0 = *(const u32x4*)(WGU + (size_t)n * 1024 + 16 * lane), w1 = *(const u32x4*)(WGU + (size_t)n * 1024 + 16 * lane + 8);
            f32x4 wa, wb, wc4, wd; unpack8(w0, wa, wb); unpack8(w1, wc4, wd);
#pragma unroll
            for (int mi = 0; mi < 3; ++mi) { const float* sh = MOD + mi * 6144 + 3 * 1024 + 16 * lane;
                const f32x4 s0 = *(const f32x4*)(sh), s1 = *(const f32x4*)(sh + 4), s2 = *(const f32x4*)(sh + 8), s3 = *(const f32x4*)(sh + 12);
                const f32x4 p = wa * s0 + wb * s1 + wc4 * s2 + wd * s3;
                const float d = wave_sum((p[0] + p[1]) + (p[2] + p[3]));
                if (lane == 0) st4f(SVGU + mi * 5632 + n, d); }
        }
    }
    GRID_SYNC();
#if DBG_STOP == 2
    { FRESH_IDS
      for (size_t i = (size_t)blockIdx.x * 512 + tid; i < (size_t)NT * 1024; i += (size_t)gridDim.x * 512) { const size_t c = i & 1023; OUT[i] = bf2f(HB[i]) + 0.25f * (bf2f(W1T[i % (2560 * 1024)]) + bf2f(WFT[i % (1024 * 1024)]) + bf2f(WGU[i % (5632 * 1024)]) + bf2f(WD[i % (2816 * 1024)])) + MOD[i % 18432]; (void)c; }
      for (size_t i = (size_t)blockIdx.x * 512 + tid; i < 131072; i += (size_t)gridDim.x * 512) { OUT[(size_t)NT * 1024 + i] = SVGU[i % 16896] + bf2f(WGLU[i]) + bf2f(WPS[i]) + bf2f(WPF[i]) + bf2f(WO[i]); }
      return; }
#endif
    { G1a g{(const char*)HB, (const char*)W1T, UH, SG}; gemm_phase(lds, g, 0, 480); }
    { G1b g{(const char*)HB, (const char*)WFT, XS}; gemm_phase(lds, g, 480, 128); }
    { G1c g{(const char*)HB, (const char*)WFT, XP}; gemm_phase(lds, g, 608, 64); }
    GRID_SYNC();
#if DBG_STOP == 1
    { FRESH_IDS
      for (size_t i = (size_t)blockIdx.x * 512 + tid; i < (size_t)NT * 1024; i += (size_t)gridDim.x * 512) { const size_t t = i >> 10, c = i & 1023; OUT[i] = bf2f(SG[t * 2048 + c]) + bf2f(SG[t * 2048 + 1024 + c]); }
      for (size_t i = (size_t)blockIdx.x * 512 + tid; i < 131072; i += (size_t)gridDim.x * 512) { float a = 0.f; for (int r = 0; r < 64; ++r) a += bf2f(XS[i * 64 + r]) + bf2f(XP[i * 32 + (r & 31)]); const size_t u = i * 48; const size_t row = u >> 8, cc = u & 255; a += bf2f(UH[row * 512 + cc]); OUT[(size_t)NT * 1024 + i] = a; }
      return; }
#endif
    { GF2 g{(const char*)D1M, (const char*)XS, TWM, Y1B}; gemm_phase(lds, g, 0, 128); }
    { GSA g{(const char*)UH, (const char*)SFM, SST}; gemm_phase(lds, g, 128, 96); }
    GRID_SYNC();
    { GF3s g{(const char*)D2M, (const char*)Y1B, YF}; gemm_phase(lds, g, 0, 64); }
    { GF3p g{(const char*)DPM, (const char*)XP, YF}; gemm_phase(lds, g, 64, 32); }
    if (blockIdx.x >= 96) {
        FRESH_IDS
        const int nw = (gridDim.x - 96) * 8;
        for (int tk = (blockIdx.x - 96) * 8 + wave; tk < 1152; tk += nw) {
            int gg, d, nc, cbase, sidx; bool smp;
            if (tk < 128) { smp = true; sidx = tk >> 6; gg = (tk >> 1) & 31; d = tk & 1; nc = 256; cbase = 256 + 256 * sidx; }
            else { const int t2 = tk - 128; smp = false; sidx = t2 >> 6; gg = (t2 >> 1) & 31; d = t2 & 1; nc = 16; cbase = 16 * sidx; }
            const f32x2 a16 = *(const f32x2*)(A16M + (size_t)((gg * 2 + d) * 64 + lane) * 2);
            float hre = 0.f, him = 0.f;
            if (smp) { hre = state_s5[(((size_t)sidx * 2 + d) * 2 + 0) * 2048 + gg * 64 + lane]; him = state_s5[(((size_t)sidx * 2 + d) * 2 + 1) * 2048 + gg * 64 + lane]; }
            const float* sp = SST + (size_t)(gg * NCH + cbase) * 256 + d * 128 + 2 * lane;
            bf16_t* hp = UH + (size_t)(gg * NCH + cbase) * 512 + 256 + d * 128 + 2 * lane;
            const int c0 = d ? nc - 1 : 0, cs = d ? -1 : 1;
            f32x2 cur[16], nxt[16];
#pragma unroll
            for (int e = 0; e < 16; ++e) cur[e] = *(const f32x2*)(sp + (ptrdiff_t)(c0 + cs * e) * 256);
            for (int cb = 0; cb < nc; cb += 16) {
                if (cb + 16 < nc) {
#pragma unroll
                    for (int e = 0; e < 16; ++e) nxt[e] = *(const f32x2*)(sp + (ptrdiff_t)(c0 + cs * (cb + 16 + e)) * 256);
                }
#pragma unroll
                for (int e = 0; e < 16; ++e) { const int c = c0 + cs * (cb + e);
                    st4f((float*)(hp + (ptrdiff_t)c * 512), __uint_as_float(cvt_pk_bf16(hre, him)));
                    const float nr = a16[0] * hre - a16[1] * him + cur[e][0], ni = a16[0] * him + a16[1] * hre + cur[e][1]; hre = nr; him = ni; }
#pragma unroll
                for (int e = 0; e < 16; ++e) cur[e] = nxt[e];
            }
            if (!smp) { float* ns = OUT + (size_t)NT * 1024 + (((size_t)sidx * 2 + d) * 2) * 2048 + gg * 64 + lane; ns[0] = hre; ns[2048] = him; }
        }
    }
    GRID_SYNC();
    { GSC g{(const char*)UH, (const char*)MEM, ZB}; gemm_phase(lds, g, 0, 96); }
    GRID_SYNC();
    { Gglu g{(const char*)ZB, (const char*)WGLU, b_glu, YS}; gemm_phase(lds, g, 0, 96); }
    GRID_SYNC();
    { Gps g{(const char*)YS, (const char*)WPS, SG, T1}; gemm_phase(lds, g, 0, 192); }
    { Gpf g{(const char*)YF, (const char*)WPF, SG, T1, MB}; gemm_phase(lds, g, 0, 192); }
    GRID_SYNC();
    { Gwo g{(const char*)MB, (const char*)WO, x_prompt, x_sample, MOD, norm2_g, X1, A2B, SSQ2}; gemm_phase(lds, g, 0, 192); }
    GRID_SYNC();
    { Ggu g{(const char*)A2B, (const char*)WGU, SSQ2, SVGU, FF}; gemm_phase(lds, g, 0, 1056); }
    GRID_SYNC();
    { Gdn g{(const char*)FF, (const char*)WD, X1, MOD, OUT, SSQ3}; gemm_phase(lds, g, 0, 192); }
    GRID_SYNC();
    { FRESH_IDS
    for (int t = gw; t < NT; t += NGW) {
        const f32x4* sp = (const f32x4*)(SSQ3 + (size_t)t * 16); const f32x4 q4 = (sp[0] + sp[1]) + (sp[2] + sp[3]);
        const float r = 1.0f / sqrtf(((q4[0] + q4[1]) + (q4[2] + q4[3])) * (1.0f / 1024.0f) + EPS);
        float* row = OUT + (size_t)t * 1024;
#pragma unroll
        for (int jx = 0; jx < 4; ++jx) { const int col = 4 * lane + 256 * jx; *(f32x4*)(row + col) = *(const f32x4*)(row + col) * r * *(const f32x4*)(fin_g + col); }
    } }
}

#undef ws
#undef OUT
constexpr int LDS_BYTES = 8 * HTB + 16384;

extern "C" void kernel_launch(void* const* d_in, const int* in_sizes, int n_in, void* d_out, int out_size, void* d_ws, size_t ws_size, hipStream_t stream) {
    static int grid = 0;
    if (grid == 0) {
        int dev = 0, cus = 0, per_cu = 0;
        hipGetDevice(&dev);
        hipDeviceGetAttribute(&cus, hipDeviceAttributeMultiprocessorCount, dev);
        if (hipFuncSetAttribute((const void*)fwd_kernel, hipFuncAttributeMaxDynamicSharedMemorySize, LDS_BYTES) != hipSuccess) fprintf(stderr, "hipFuncSetAttribute failed\n");
        if (hipOccupancyMaxActiveBlocksPerMultiprocessor(&per_cu, (const void*)fwd_kernel, 512, LDS_BYTES) != hipSuccess || per_cu < 1) { fprintf(stderr, "occupancy query: %d\n", per_cu); per_cu = 1; }
        (void)hipGetLastError();
        grid = cus > 0 ? cus : 256;
        if (ws_size < WS_END) fprintf(stderr, "workspace too small: %zu < %zu\n", ws_size, (size_t)WS_END);
    }
    hipMemsetAsync((char*)d_ws + WS_CTL, 0, 4096, stream);
    Params p{};
    for (int i = 0; i < 27; ++i) p.in[i] = (const float*)d_in[i];
    p.out = (float*)d_out; p.wsp = (unsigned char*)d_ws;
    void* args[] = {&p};
    hipError_t e = hipLaunchCooperativeKernel((const void*)fwd_kernel, dim3(grid), dim3(512), args, LDS_BYTES, stream);
    if (e != hipSuccess) fprintf(stderr, "cooperative launch failed: %s (grid %d)\n", hipGetErrorString(e), grid);
}
```

```cpp
#include <hip/hip_runtime.h>
#include <hip/hip_cooperative_groups.h>
#include <cstdio>
#include <cstdint>
namespace cg = cooperative_groups;

#define LAS __attribute__((address_space(3)))
typedef unsigned short bf16_t;
typedef short bf16x8 __attribute__((ext_vector_type(8)));
typedef float f32x4 __attribute__((ext_vector_type(4)));
typedef float f32x2 __attribute__((ext_vector_type(2)));
typedef unsigned u32x4 __attribute__((ext_vector_type(4)));
typedef unsigned u32x2 __attribute__((ext_vector_type(2)));

#ifndef DBG_STOP
#define DBG_STOP 0
#endif
constexpr int NT = 12288, NTP = 4096, DM = 1024, NCH = 768, DFF = 2816;
constexpr float EPS = 1e-6f;

constexpr size_t AL(size_t x) { return (x + 255) & ~(size_t)255; }
constexpr size_t WS_CTL = 0;
constexpr size_t WS_MOD = 4096;
constexpr size_t WS_SVGU = WS_MOD + AL(3 * 6144 * 4);
constexpr size_t WS_MODP = AL(WS_SVGU + 3 * 5632 * 4);
constexpr size_t WS_SSQ2 = AL(WS_MODP + 32 * 3 * 6144 * 4);
constexpr size_t WS_SSQ3 = AL(WS_SSQ2 + (size_t)NT * 16 * 4);
constexpr size_t WS_W1T = AL(WS_SSQ3 + (size_t)NT * 16 * 4);
constexpr size_t WS_WFT = WS_W1T + 2560 * 1024 * 2;
constexpr size_t WS_WGLU = WS_WFT + 1024 * 1024 * 2;
constexpr size_t WS_WPS = WS_WGLU + 512 * 512 * 2;
constexpr size_t WS_WPF = WS_WPS + 1024 * 512 * 2;
constexpr size_t WS_WO = WS_WPF + 1024 * 512 * 2;
constexpr size_t WS_WGU = WS_WO + 1024 * 1024 * 2;
constexpr size_t WS_WD = WS_WGU + (size_t)5632 * 1024 * 2;
constexpr size_t WS_R1 = AL(WS_WD + (size_t)1024 * 2816 * 2);
constexpr size_t WS_R3 = WS_R1 + (size_t)NT * 2048 * 2;
constexpr size_t WS_R4 = WS_R3 + (size_t)NT * 1024 * 2;
constexpr size_t WS_XP = WS_R4 + (size_t)16777216;
constexpr size_t WS_R5 = WS_R4 + (size_t)NT * 1024 * 2;
constexpr size_t WS_YS = WS_R5 + (size_t)NT * 512 * 2;
constexpr size_t WS_YF = WS_YS + (size_t)NT * 512 * 2;
constexpr size_t WS_R2 = WS_YF + (size_t)NT * 512 * 2;
constexpr size_t WS_SF = WS_R2 + (size_t)NT * 1024 * 2;
constexpr size_t WS_ME = WS_SF + (size_t)32 * 256 * 256 * 2;
constexpr size_t WS_KK = WS_ME + (size_t)32 * 256 * 512 * 2;
constexpr size_t WS_A16 = WS_KK + (size_t)32 * 2 * 4096 * 4;
constexpr size_t WS_D1 = WS_A16 + 32 * 2 * 64 * 8;
constexpr size_t WS_D2 = WS_D1 + 256 * 256 * 2;
constexpr size_t WS_DP = WS_D2 + 256 * 512 * 2;
constexpr size_t WS_TW = WS_DP + 256 * 512 * 2;
constexpr size_t WS_BAR = WS_TW + 64 * 64 * 8;
constexpr size_t WS_END = WS_BAR + 16384;

__device__ __forceinline__ unsigned cvt_pk_bf16(float lo, float hi) { unsigned r; asm volatile("v_cvt_pk_bf16_f32 %0, %1, %2" : "=v"(r) : "v"(lo), "v"(hi)); return r; }
__device__ __forceinline__ float bf2f(unsigned short b) { return __uint_as_float(((unsigned)b) << 16); }
__device__ __forceinline__ float bflo(unsigned w) { return __uint_as_float(w << 16); }
__device__ __forceinline__ float bfhi(unsigned w) { return __uint_as_float(w & 0xffff0000u); }
__device__ __forceinline__ float sigm(float x) { return __builtin_amdgcn_rcpf(1.0f + __expf(-x)); }
__device__ __forceinline__ float gelu_tanh(float x) { const float u = 0.7978845608028654f * (x + 0.044715f * x * x * x); return x * sigm(2.0f * u); }
__device__ __forceinline__ float wave_sum(float v) {
#pragma unroll
    for (int o = 1; o < 64; o <<= 1) v += __shfl_xor(v, o);
    return v;
}
__device__ __forceinline__ void st16(void* p, u32x4 v) { asm volatile("global_store_dwordx4 %0, %1, off sc1\n\ts_nop 1" :: "v"(p), "v"(v) : "memory"); }
__device__ __forceinline__ void st16f(void* p, f32x4 v) { asm volatile("global_store_dwordx4 %0, %1, off sc1\n\ts_nop 1" :: "v"(p), "v"(v) : "memory"); }
__device__ __forceinline__ void st4f(float* p, float v) { asm volatile("global_store_dword %0, %1, off sc1\n\ts_nop 1" :: "v"(p), "v"(v) : "memory"); }
__device__ __forceinline__ void st2(bf16_t* p, unsigned v) { asm volatile("global_store_short %0, %1, off sc1\n\ts_nop 1" :: "v"(p), "v"(v) : "memory"); }
__device__ __forceinline__ u32x4 pack8(f32x4 a, f32x4 b) { u32x4 w; w.x = cvt_pk_bf16(a[0], a[1]); w.y = cvt_pk_bf16(a[2], a[3]); w.z = cvt_pk_bf16(b[0], b[1]); w.w = cvt_pk_bf16(b[2], b[3]); return w; }
__device__ __forceinline__ void unpack8(u32x4 w, f32x4& a, f32x4& b) { a = (f32x4){bflo(w.x), bfhi(w.x), bflo(w.y), bfhi(w.y)}; b = (f32x4){bflo(w.z), bfhi(w.z), bflo(w.w), bfhi(w.w)}; }
__device__ __forceinline__ void sincos_d(double th, double& s, double& c) {
    const double k = rint(th * 0.63661977236758134308);
    const double r = fma(-k, 6.123233995736766e-17, fma(-k, 1.5707963267948966, th));
    const double x2 = r * r;
    double sp = -7.6471637318198165e-13; sp = sp * x2 + 1.6059043836821613e-10; sp = sp * x2 - 2.5052108385441719e-08; sp = sp * x2 + 2.7557319223985891e-06;
    sp = sp * x2 - 1.9841269841269841e-04; sp = sp * x2 + 8.3333333333333333e-03; sp = sp * x2 - 1.6666666666666667e-01; sp = r + r * x2 * sp;
    double cp = 4.7794773323873853e-14; cp = cp * x2 - 1.1470745597729725e-11; cp = cp * x2 + 2.0876756987868099e-09; cp = cp * x2 - 2.7557319223985891e-07;
    cp = cp * x2 + 2.4801587301587302e-05; cp = cp * x2 - 1.3888888888888889e-03; cp = cp * x2 + 4.1666666666666667e-02; cp = cp * x2 - 0.5; cp = 1.0 + x2 * cp;
    const int q = ((int)k) & 3;
    s = (q == 0) ? sp : (q == 1) ? cp : (q == 2) ? -sp : -cp;
    c = (q == 0) ? cp : (q == 1) ? -sp : (q == 2) ? -cp : sp;
}
__device__ __forceinline__ void sincos_frac(int j, int N, float& s, float& c) { double ds, dc; sincos_d(6.283185307179586476925 * (double)(j & (N - 1)) / (double)N, ds, dc); s = (float)ds; c = (float)dc; }

#define XB_TMO      128
#define XB_XCNT(j)  (256  + 64 * (j))
#define XB_XSUB(j)  (1280 + 64 * (j))
#define XB_XGEN(j)  (2304 + 64 * (j))
#define XB_TOP      3328
#define XB_TOPGEN   3392
#define XCD_BAR_WORDS 3456
#define XB_SPIN_CAP (1u << 18)
__device__ __forceinline__ unsigned xb_ld(unsigned* p)              { return __hip_atomic_load(p, __ATOMIC_RELAXED, __HIP_MEMORY_SCOPE_AGENT); }
__device__ __forceinline__ unsigned xb_add(unsigned* p, unsigned v) { return __hip_atomic_fetch_add(p, v, __ATOMIC_RELAXED, __HIP_MEMORY_SCOPE_AGENT); }
__device__ __forceinline__ unsigned xb_xcc_id() { return (unsigned)__builtin_amdgcn_s_getreg((3 << 11) | 20) & 0xFu; }
#define XB_SPIN(cond, bar) do { unsigned _sp = 0; while (cond) { __builtin_amdgcn_s_sleep(1); \
    if ((++_sp & 255u) == 0u) { if (xb_ld(&(bar)[XB_TMO])) break; if (_sp > XB_SPIN_CAP) { atomicAdd(&(bar)[XB_TMO], 1u); break; } } } } while (0)
struct XcdBarrier { unsigned* bar; unsigned x; volatile LAS unsigned* st; };
__device__ __forceinline__ XcdBarrier xcd_barrier_post(unsigned* bar, volatile LAS unsigned* st) {
    XcdBarrier b; b.bar = bar; b.x = xb_xcc_id(); b.st = st;
    if (threadIdx.x == 0) (void)xb_add(&bar[XB_XCNT(b.x)], 1u);
    return b;
}
__device__ __forceinline__ void xcd_barrier_complete(unsigned* bar, unsigned x, unsigned& nloc, unsigned& nx) {
    const unsigned G = gridDim.x * gridDim.y * gridDim.z;
    unsigned sum, cnt, mine, sp = 0u;
    for (;;) {
        sum = 0u; cnt = 0u; mine = 0u;
#pragma unroll
        for (unsigned j = 0; j < 16; ++j) { const unsigned c = xb_ld(&bar[XB_XCNT(j)]); sum += c; cnt += (c > 0u) ? 1u : 0u; mine = (j == x) ? c : mine; }
        if (sum == G) break;
        __builtin_amdgcn_s_sleep(1);
        if ((++sp & 255u) == 0u) { if (xb_ld(&bar[XB_TMO])) break; if (sp > XB_SPIN_CAP) { atomicAdd(&bar[XB_TMO], 1u); break; } }
    }
    nloc = mine > 0u ? mine : 1u; nx = cnt > 0u ? cnt : 1u;
}
__device__ __forceinline__ void xcd_barrier(const XcdBarrier& b) {
    asm volatile("s_waitcnt vmcnt(0)" ::: "memory");
    __syncthreads();
    if (threadIdx.x == 0) {
        unsigned* bar = b.bar;
        __builtin_amdgcn_s_waitcnt(0);
        unsigned nloc = b.st[0], nx = b.st[1];
        if (nloc == 0u) { xcd_barrier_complete(bar, b.x, nloc, nx); b.st[0] = nloc; b.st[1] = nx; }
        const unsigned old = xb_add(&bar[XB_XSUB(b.x)], 1u);
        const unsigned gen = old / nloc;
        if (old + 1u == (gen + 1u) * nloc) {
            __builtin_amdgcn_fence(__ATOMIC_RELEASE, "agent");
            asm volatile("s_waitcnt vmcnt(0)" ::: "memory");
            const unsigned og = xb_add(&bar[XB_TOP], 1u);
            const unsigned tg = og / nx;
            if (og + 1u == (tg + 1u) * nx) xb_add(&bar[XB_TOPGEN], 1u);
            else XB_SPIN(xb_ld(&bar[XB_TOPGEN]) == tg, bar);
            __builtin_amdgcn_fence(__ATOMIC_ACQUIRE, "agent");
            xb_add(&bar[XB_XGEN(b.x)], 1u);
            asm volatile("s_waitcnt vmcnt(0)" ::: "memory");
        } else {
            XB_SPIN(xb_ld(&bar[XB_XGEN(b.x)]) == gen, bar);
            __builtin_amdgcn_fence(__ATOMIC_ACQUIRE, "agent");
            asm volatile("s_waitcnt vmcnt(0)" ::: "memory");
        }
    }
    __syncthreads();
}

constexpr int HTB = 128 * 64 * 2;
__device__ __forceinline__ int lds_byte(int r, int c) { const int st = (r >> 4) * 2 + (c >> 5), rr = r & 15, cc = c & 31, ob = rr * 64 + cc * 2; return st * 1024 + (ob ^ (((ob >> 9) & 1) << 5)); }
__device__ __forceinline__ void stage_rc(int b, int& R, int& C) { const int st = b / 1024, sb = b % 1024, swz = sb ^ (((sb >> 9) & 1) << 5); R = (st >> 1) * 16 + swz / 64; C = (st & 1) * 32 + (swz % 64) / 2; }
__device__ __forceinline__ int perm32(int rho) { const int n = rho >> 4, i = rho & 15; return 8 * (i >> 2) + 4 * n + (i & 3); }
struct Unit { const char* A; const char* B; int pm, pn; };
__device__ __forceinline__ void tile_of(int j, int nM, int nN, int& pm, int& pn) {
    const int nwg = nM * nN; int wgid = j;
    { const int q = nwg / 8, r = nwg % 8, xcd = wgid % 8, off = wgid / 8; wgid = (xcd < r ? xcd * (q + 1) : r * (q + 1) + (xcd - r) * q) + off; }
    const int nig = 8 * nN, gid = wgid / nig, fm = gid * 8, gsz = (nM - fm) < 8 ? (nM - fm) : 8;
    pm = fm + ((wgid % nig) % gsz); pn = (wgid % nig) / gsz;
}
template <class G>
__device__ __forceinline__ void gemm_phase(LAS unsigned char* lds, const G& g, const int L0, const int count) {
    constexpr int K = G::K, nt = K / 64;
    static_assert(nt % 2 == 0 && nt >= 2, "K");
    int tid = threadIdx.x; asm volatile("" : "+v"(tid));
    const int wid = __builtin_amdgcn_readfirstlane(tid >> 6), lane = tid & 63, wr = wid >> 2, wc = wid & 3, fr = lane & 15, fq = lane >> 4;
    const int Gn = gridDim.x;
    int j = ((int)blockIdx.x - L0) % Gn; if (j < 0) j += Gn;
    if (j >= count) return;
    unsigned voffA[2], voffB[2];
#pragma unroll
    for (int i = 0; i < 2; ++i) { int R, C; stage_rc(tid * 16 + i * 8192, R, C); const int Rb = G::PERM ? (R & ~31) + perm32(R & 31) : R;
        voffA[i] = g.offA(R) + (unsigned)C * 2u; voffB[i] = g.offB(Rb) + (unsigned)C * 2u; }
    const size_t kstep = 128, hsA = G::HSA, hsB = G::HSB;
    const unsigned ldsw = (unsigned)wid * 1024u;
    const int aoff = lds_byte(wr * 64 + fr, fq * 8), boff = lds_byte(wc * 32 + fr, fq * 8);
#define PG8_SA(b, h) (((b) * 2 + (h)) * HTB)
#define PG8_SB(b, h) ((4 + (b) * 2 + (h)) * HTB)
#define PG8_STAGE(bufoff, gbase, voff) do { _Pragma("unroll") for (int _i = 0; _i < 2; ++_i) \
        __builtin_amdgcn_global_load_lds((const unsigned*)((const char*)(gbase) + (voff)[_i]), (LAS unsigned*)(lds + (bufoff) + ldsw + _i * 8192), 16, 0, 0); } while (0)
#define PG8_LDA(dst, b, h) do { _Pragma("unroll") for (int m = 0; m < 4; ++m) _Pragma("unroll") for (int k = 0; k < 2; ++k) dst[m][k] = *(const LAS bf16x8*)(lds + PG8_SA(b, h) + aoff + m * 2048 + k * 1024); } while (0)
#define PG8_LDB(dst, b, h) do { _Pragma("unroll") for (int n = 0; n < 2; ++n) _Pragma("unroll") for (int k = 0; k < 2; ++k) dst[n][k] = *(const LAS bf16x8*)(lds + PG8_SB(b, h) + boff + n * 2048 + k * 1024); } while (0)
#define PG8_MMA(ai, bj, At, Bt) do { __builtin_amdgcn_s_setprio(1); _Pragma("unroll") for (int m = 0; m < 4; ++m) _Pragma("unroll") for (int n = 0; n < 2; ++n) _Pragma("unroll") for (int k = 0; k < 2; ++k) \
        acc[ai][bj][m][n] = __builtin_amdgcn_mfma_f32_16x16x32_bf16(Bt[n][k], At[m][k], acc[ai][bj][m][n], 0, 0, 0); __builtin_amdgcn_s_setprio(0); } while (0)
#ifdef SAFE_ENGINE
#define PG8_WAIT_V(n) asm volatile("s_waitcnt vmcnt(0)" ::: "memory")
#else
#define PG8_WAIT_V(n) asm volatile("s_waitcnt vmcnt(" #n ")" ::: "memory")
#endif
#define PG8_WAIT_L(n) asm volatile("s_waitcnt lgkmcnt(" #n ")" ::: "memory")
#define PG8_BAR __builtin_amdgcn_s_barrier()
#define PG8_SCHED __builtin_amdgcn_sched_barrier(0)
    Unit cur, nxt;
    g.unit(j, cur); asm volatile("" : "+s"(cur.A), "+s"(cur.B));
    f32x4 acc[2][2][4][2];
#pragma unroll
    for (int a = 0; a < 2; ++a)
#pragma unroll
        for (int b = 0; b < 2; ++b)
#pragma unroll
            for (int m = 0; m < 4; ++m)
#pragma unroll
                for (int n = 0; n < 2; ++n) acc[a][b][m][n] = (f32x4){0.f, 0.f, 0.f, 0.f};
    bf16x8 At[4][2], B0[2][2], B1[2][2];
    const char* cA = cur.A; const char* cB = cur.B;
    PG8_STAGE(PG8_SB(0, 0), cB, voffB); PG8_STAGE(PG8_SB(0, 1), cB + hsB, voffB); PG8_STAGE(PG8_SA(0, 0), cA, voffA); PG8_STAGE(PG8_SA(0, 1), cA + hsA, voffA);
    if (wr == 1) PG8_BAR;
    PG8_WAIT_V(2); PG8_BAR;
    PG8_STAGE(PG8_SB(1, 0), cB + kstep, voffB); PG8_STAGE(PG8_SA(1, 0), cA + kstep, voffA); PG8_STAGE(PG8_SB(1, 1), cB + hsB + kstep, voffB);
    PG8_WAIT_V(6); PG8_BAR;
    for (;;) {
        const bool has_next = (j + Gn < count);
        if (has_next) { g.unit(j + Gn, nxt); asm volatile("" : "+s"(nxt.A), "+s"(nxt.B)); }
        const char* nA = has_next ? nxt.A : cA; const char* nB = has_next ? nxt.B : cB;
        for (int t = 0; t < nt; t += 2) {
            const bool last = (t == nt - 2);
            const char* a1 = cA + (size_t)(t + 1) * kstep;
            const char* a2 = last ? nA : cA + (size_t)(t + 2) * kstep; const char* b2 = last ? nB : cB + (size_t)(t + 2) * kstep;
            const char* a3 = a2 + kstep; const char* b3 = b2 + kstep;
            PG8_LDB(B0, 0, 0); PG8_LDB(B1, 0, 1); PG8_SCHED; PG8_LDA(At, 0, 0); PG8_STAGE(PG8_SA(1, 1), a1 + hsA, voffA);
            PG8_WAIT_V(8); PG8_WAIT_L(0); PG8_BAR; PG8_MMA(0, 0, At, B0); PG8_MMA(0, 1, At, B1); PG8_BAR; PG8_SCHED;
            PG8_LDA(At, 0, 1); PG8_STAGE(PG8_SB(0, 0), b2, voffB); PG8_STAGE(PG8_SB(0, 1), b2 + hsB, voffB); PG8_STAGE(PG8_SA(0, 0), a2, voffA);
            PG8_WAIT_V(8); PG8_WAIT_L(0); PG8_BAR; PG8_MMA(1, 0, At, B0); PG8_MMA(1, 1, At, B1); PG8_BAR; PG8_SCHED;
            PG8_LDB(B0, 1, 0); PG8_LDB(B1, 1, 1); PG8_SCHED; PG8_LDA(At, 1, 0); PG8_STAGE(PG8_SA(0, 1), a2 + hsA, voffA);
            PG8_WAIT_V(8); PG8_WAIT_L(0); PG8_BAR; PG8_MMA(0, 0, At, B0); PG8_MMA(0, 1, At, B1); PG8_BAR; PG8_SCHED;
            PG8_LDA(At, 1, 1); PG8_STAGE(PG8_SB(1, 0), b3, voffB); PG8_STAGE(PG8_SB(1, 1), b3 + hsB, voffB); PG8_STAGE(PG8_SA(1, 0), a3, voffA);
            PG8_WAIT_V(8); PG8_WAIT_L(0); PG8_BAR; PG8_MMA(1, 0, At, B0); PG8_MMA(1, 1, At, B1); PG8_BAR; PG8_SCHED;
        }
        if (wr == 0) PG8_BAR;
        g.epi(acc, cur, wr, wc, fr, fq);
        if (!has_next) break;
#pragma unroll
        for (int a = 0; a < 2; ++a)
#pragma unroll
            for (int b = 0; b < 2; ++b)
#pragma unroll
                for (int m = 0; m < 4; ++m)
#pragma unroll
                    for (int n = 0; n < 2; ++n) acc[a][b][m][n] = (f32x4){0.f, 0.f, 0.f, 0.f};
        cur = nxt; cA = nA; cB = nB; j += Gn;
        if (wr == 1) PG8_BAR;
    }
    PG8_WAIT_V(0);
    PG8_BAR;
#undef PG8_SA
#undef PG8_SB
#undef PG8_STAGE
#undef PG8_LDA
#undef PG8_LDB
#undef PG8_MMA
#undef PG8_WAIT_V
#undef PG8_WAIT_L
#undef PG8_BAR
#undef PG8_SCHED
}

#define EPI_ARGS const f32x4 (&acc)[2][2][4][2], const Unit& u, int wr, int wc, int fr, int fq
struct G1a {
    static constexpr bool PERM = true; static constexpr int K = 1024; static constexpr size_t HSA = 128 * 2048, HSB = 128 * 2048;
    const char* HB; const char* W; bf16_t* UH; bf16_t* SG;
    __device__ __forceinline__ unsigned offA(int R) const { return (unsigned)R * 2048u; }
    __device__ __forceinline__ unsigned offB(int R) const { return (unsigned)R * 2048u; }
    __device__ __forceinline__ void unit(int j, Unit& u) const { tile_of(j, 48, 10, u.pm, u.pn); u.A = HB + (size_t)u.pm * 256 * 2048; u.B = W + (size_t)u.pn * 256 * 2048; }
    __device__ __forceinline__ void epi(EPI_ARGS) const {
#pragma unroll
        for (int ai = 0; ai < 2; ++ai)
#pragma unroll
            for (int m = 0; m < 4; ++m) { const int t = u.pm * 256 + 128 * ai + 64 * wr + 16 * m + fr;
#pragma unroll
                for (int bj = 0; bj < 2; ++bj) { const int col = u.pn * 256 + 128 * bj + 32 * wc + 8 * fq; const f32x4 a = acc[ai][bj][m][0], b = acc[ai][bj][m][1];
                    if (u.pn < 2) { const int gg = col >> 4, h0 = col & 15; st16(UH + ((size_t)(gg * NCH + (t >> 4)) * 512 + (t & 15) * 16 + h0), pack8(a, b)); }
                    else { f32x4 sa, sb;
#pragma unroll
                        for (int q = 0; q < 4; ++q) { sa[q] = sigm(a[q]); sb[q] = sigm(b[q]); }
                        st16(SG + ((size_t)t * 2048 + (col - 512)), pack8(sa, sb)); } } }
    }
};
struct G1b {
    static constexpr bool PERM = true; static constexpr int K = 1024; static constexpr size_t HSA = 128 * 2048, HSB = 2 * 2048;
    const char* HB; const char* W; bf16_t* XS;
    __device__ __forceinline__ unsigned offA(int R) const { return (unsigned)R * 2048u; }
    __device__ __forceinline__ unsigned offB(int R) const { return (unsigned)(64 * (R & 63) + (R >> 6)) * 2048u; }
    __device__ __forceinline__ void unit(int j, Unit& u) const { tile_of(j, 4, 32, u.pm, u.pn); u.A = W + (size_t)u.pm * 256 * 2048; const int s = u.pn >> 4, a0 = 4 * (u.pn & 15); u.B = HB + (size_t)(NTP + 4096 * s + a0) * 2048; }
    __device__ __forceinline__ void epi(EPI_ARGS) const {
        const int s = u.pn >> 4, a0 = 4 * (u.pn & 15);
#pragma unroll
        for (int ai = 0; ai < 2; ++ai)
#pragma unroll
            for (int m = 0; m < 4; ++m) { const int q = 64 * wr + 16 * m + fr, gq = u.pm * 128 + q;
#pragma unroll
                for (int bj = 0; bj < 2; ++bj) { const int la = a0 + 2 * bj + (wc >> 1), lb0 = 32 * (wc & 1) + 8 * fq;
                    const size_t idx = ((((size_t)((gq >> 1) * 2 + s) * 64 + la) * 2 + (gq & 1)) * 2 + ai) * 64 + lb0;
                    st16(XS + idx, pack8(acc[ai][bj][m][0], acc[ai][bj][m][1])); } }
    }
};
struct G1c {
    static constexpr bool PERM = true; static constexpr int K = 1024; static constexpr size_t HSA = 128 * 2048, HSB = 128 * 2048;
    const char* HB; const char* W; bf16_t* XP;
    __device__ __forceinline__ unsigned offA(int R) const { return (unsigned)R * 2048u; }
    __device__ __forceinline__ unsigned offB(int R) const { return (unsigned)R * 2048u; }
    __device__ __forceinline__ void unit(int j, Unit& u) const { tile_of(j, 4, 16, u.pm, u.pn); u.A = W + (size_t)u.pm * 256 * 2048; u.B = HB + (size_t)(256 * u.pn) * 2048; }
    __device__ __forceinline__ void epi(EPI_ARGS) const {
#pragma unroll
        for (int ai = 0; ai < 2; ++ai)
#pragma unroll
            for (int m = 0; m < 4; ++m) { const int q = 64 * wr + 16 * m + fr, gq = u.pm * 128 + q;
#pragma unroll
                for (int bj = 0; bj < 2; ++bj) { const int l0 = 128 * bj + 32 * wc + 8 * fq;
                    const size_t idx = ((size_t)(u.pn * 512 + gq) * 2 + ai) * 256 + l0;
                    st16(XP + idx, pack8(acc[ai][bj][m][0], acc[ai][bj][m][1])); } }
    }
};
struct Gglu {
    static constexpr bool PERM = true; static constexpr int K = 512; static constexpr size_t HSA = 128 * 1024, HSB = 128 * 1024;
    const char* ZB; const char* W; const float* bias; bf16_t* YS;
    __device__ __forceinline__ unsigned offA(int R) const { return (unsigned)R * 1024u; }
    __device__ __forceinline__ unsigned offB(int R) const { return (unsigned)R * 1024u; }
    __device__ __forceinline__ void unit(int j, Unit& u) const { tile_of(j, 48, 2, u.pm, u.pn); u.A = ZB + (size_t)u.pm * 256 * 1024; u.B = W + (size_t)u.pn * 256 * 1024; }
    __device__ __forceinline__ void epi(EPI_ARGS) const {
#pragma unroll
        for (int bj = 0; bj < 2; ++bj) { const int col = u.pn * 256 + 128 * bj + 32 * wc + 8 * fq;
            const f32x4 b0 = *(const f32x4*)(bias + col), b1 = *(const f32x4*)(bias + col + 4);
#pragma unroll
            for (int ai = 0; ai < 2; ++ai)
#pragma unroll
                for (int m = 0; m < 4; ++m) { const int t = u.pm * 256 + 128 * ai + 64 * wr + 16 * m + fr;
                    f32x4 z0, z1; unpack8(*(const u32x4*)((const bf16_t*)ZB + (size_t)t * 512 + col), z0, z1);
                    f32x4 a = acc[ai][bj][m][0] + b0, b = acc[ai][bj][m][1] + b1;
#pragma unroll
                    for (int q = 0; q < 4; ++q) { a[q] = z0[q] * sigm(a[q]); b[q] = z1[q] * sigm(b[q]); }
                    st16(YS + (size_t)t * 512 + col, pack8(a, b)); asm volatile("" ::: "memory"); } }
    }
};
struct Gps {
    static constexpr bool PERM = true; static constexpr int K = 512; static constexpr size_t HSA = 128 * 1024, HSB = 128 * 1024;
    const char* A; const char* W; const bf16_t* SG; float* T1;
    __device__ __forceinline__ unsigned offA(int R) const { return (unsigned)R * 1024u; }
    __device__ __forceinline__ unsigned offB(int R) const { return (unsigned)R * 1024u; }
    __device__ __forceinline__ void unit(int j, Unit& u) const { tile_of(j, 48, 4, u.pm, u.pn); u.A = A + (size_t)u.pm * 256 * 1024; u.B = W + (size_t)u.pn * 256 * 1024; }
    __device__ __forceinline__ void epi(EPI_ARGS) const {
#pragma unroll
        for (int ai = 0; ai < 2; ++ai)
#pragma unroll
            for (int m = 0; m < 4; ++m) { const int t = u.pm * 256 + 128 * ai + 64 * wr + 16 * m + fr;
#pragma unroll
                for (int bj = 0; bj < 2; ++bj) { const int col = u.pn * 256 + 128 * bj + 32 * wc + 8 * fq;
                    f32x4 s0, s1; unpack8(*(const u32x4*)(SG + (size_t)t * 2048 + col), s0, s1);
                    *(f32x4*)(T1 + (size_t)t * 1024 + col) = s0 * acc[ai][bj][m][0]; *(f32x4*)(T1 + (size_t)t * 1024 + col + 4) = s1 * acc[ai][bj][m][1];     } asm volatile("" ::: "memory"); }
    }
};
struct Gpf {
    static constexpr bool PERM = true; static constexpr int K = 512; static constexpr size_t HSA = 128 * 1024, HSB = 128 * 1024;
    const char* A; const char* W; const bf16_t* SG; const float* T1; bf16_t* MB;
    __device__ __forceinline__ unsigned offA(int R) const { return (unsigned)R * 1024u; }
    __device__ __forceinline__ unsigned offB(int R) const { return (unsigned)R * 1024u; }
    __device__ __forceinline__ void unit(int j, Unit& u) const { tile_of(j, 48, 4, u.pm, u.pn); u.A = A + (size_t)u.pm * 256 * 1024; u.B = W + (size_t)u.pn * 256 * 1024; }
    __device__ __forceinline__ void epi(EPI_ARGS) const {
#pragma unroll
        for (int ai = 0; ai < 2; ++ai)
#pragma unroll
            for (int m = 0; m < 4; ++m) { const int t = u.pm * 256 + 128 * ai + 64 * wr + 16 * m + fr;
#pragma unroll
                for (int bj = 0; bj < 2; ++bj) { const int col = u.pn * 256 + 128 * bj + 32 * wc + 8 * fq;
                    f32x4 s0, s1; unpack8(*(const u32x4*)(SG + (size_t)t * 2048 + 1024 + col), s0, s1);
                    const f32x4 t0 = *(const f32x4*)(T1 + (size_t)t * 1024 + col), t1 = *(const f32x4*)(T1 + (size_t)t * 1024 + col + 4);
                    st16(MB + (size_t)t * 1024 + col, pack8(t0 + s0 * acc[ai][bj][m][0], t1 + s1 * acc[ai][bj][m][1])); } asm volatile("" ::: "memory"); }
    }
};
struct Gwo {
    static constexpr bool PERM = true; static constexpr int K = 1024; static constexpr size_t HSA = 128 * 2048, HSB = 128 * 2048;
    const char* A; const char* W; const float* xp; const float* xs; const float* MOD; const float* g2; float* X1; bf16_t* A2B; float* SSQ;
    __device__ __forceinline__ unsigned offA(int R) const { return (unsigned)R * 2048u; }
    __device__ __forceinline__ unsigned offB(int R) const { return (unsigned)R * 2048u; }
    __device__ __forceinline__ void unit(int j, Unit& u) const { tile_of(j, 48, 4, u.pm, u.pn); u.A = A + (size_t)u.pm * 256 * 2048; u.B = W + (size_t)u.pn * 256 * 2048; }
    __device__ __forceinline__ void epi(EPI_ARGS) const {
        const int mi = u.pm < 16 ? 0 : (u.pm < 32 ? 1 : 2);
        const float* xin = u.pm < 16 ? xp + (size_t)u.pm * 256 * 1024 : xs + (size_t)(u.pm - 16) * 256 * 1024;
        const float* md = MOD + mi * 6144;
        float ss[2][4];
#pragma unroll
        for (int ai = 0; ai < 2; ++ai)
#pragma unroll
            for (int m = 0; m < 4; ++m) ss[ai][m] = 0.f;
#pragma unroll
        for (int bj = 0; bj < 2; ++bj) { const int col = u.pn * 256 + 128 * bj + 32 * wc + 8 * fq;
            const f32x4 ga = *(const f32x4*)(md + 2048 + col), gb = *(const f32x4*)(md + 2048 + col + 4);
            const f32x4 sa = (*(const f32x4*)(md + 4096 + col) + 1.0f) * *(const f32x4*)(g2 + col), sb = (*(const f32x4*)(md + 4096 + col + 4) + 1.0f) * *(const f32x4*)(g2 + col + 4);
#pragma unroll
            for (int ai = 0; ai < 2; ++ai)
#pragma unroll
                for (int m = 0; m < 4; ++m) { const int rl = 128 * ai + 64 * wr + 16 * m + fr; const size_t t = (size_t)u.pm * 256 + rl;
                    const f32x4 x0 = *(const f32x4*)(xin + (size_t)rl * 1024 + col) + ga * acc[ai][bj][m][0], x1 = *(const f32x4*)(xin + (size_t)rl * 1024 + col + 4) + gb * acc[ai][bj][m][1];
                    *(f32x4*)(X1 + t * 1024 + col) = x0; *(f32x4*)(X1 + t * 1024 + col + 4) = x1;
                    st16(A2B + t * 1024 + col, pack8(x0 * sa, x1 * sb));
                    ss[ai][m] += (x0[0] * x0[0] + x0[1] * x0[1]) + (x0[2] * x0[2] + x0[3] * x0[3]) + (x1[0] * x1[0] + x1[1] * x1[1]) + (x1[2] * x1[2] + x1[3] * x1[3]);
                    asm volatile("" ::: "memory"); } }
#pragma unroll
        for (int ai = 0; ai < 2; ++ai)
#pragma unroll
            for (int m = 0; m < 4; ++m) { float s = ss[ai][m]; s += __shfl_xor(s, 16); s += __shfl_xor(s, 32);
                if (fq == 0) st4f(SSQ + ((size_t)u.pm * 256 + 128 * ai + 64 * wr + 16 * m + fr) * 16 + u.pn * 4 + wc, s); }
    }
};
struct Ggu {
    static constexpr bool PERM = true; static constexpr int K = 1024; static constexpr size_t HSA = 128 * 2048, HSB = 128 * 2048;
    const char* A; const char* W; const float* SSQ; const float* SV; bf16_t* FF;
    __device__ __forceinline__ unsigned offA(int R) const { return (unsigned)R * 2048u; }
    __device__ __forceinline__ unsigned offB(int R) const { return (unsigned)R * 2048u; }
    __device__ __forceinline__ void unit(int j, Unit& u) const { tile_of(j, 48, 22, u.pm, u.pn); u.A = A + (size_t)u.pm * 256 * 2048; u.B = W + (size_t)u.pn * 256 * 2048; }
    __device__ __forceinline__ void epi(EPI_ARGS) const {
        const int mi = u.pm < 16 ? 0 : (u.pm < 32 ? 1 : 2);
        const float* sv = SV + mi * 5632 + u.pn * 256 + 32 * wc + 8 * fq;
        const f32x4 g0 = *(const f32x4*)(sv), g1 = *(const f32x4*)(sv + 4), u0 = *(const f32x4*)(sv + 128), u1 = *(const f32x4*)(sv + 132);
        const int col = u.pn * 128 + 32 * wc + 8 * fq;
#pragma unroll
        for (int ai = 0; ai < 2; ++ai)
#pragma unroll
            for (int m = 0; m < 4; ++m) { const size_t t = (size_t)u.pm * 256 + 128 * ai + 64 * wr + 16 * m + fr;
                const f32x4* sp = (const f32x4*)(SSQ + t * 16); const f32x4 q4 = (sp[0] + sp[1]) + (sp[2] + sp[3]);
                const float r = __builtin_amdgcn_rsqf(((q4[0] + q4[1]) + (q4[2] + q4[3])) * (1.0f / 1024.0f) + EPS);
                f32x4 ga = acc[ai][0][m][0] * r + g0, gb = acc[ai][0][m][1] * r + g1; const f32x4 ua = acc[ai][1][m][0] * r + u0, ub = acc[ai][1][m][1] * r + u1;
#pragma unroll
                for (int q = 0; q < 4; ++q) { ga[q] = ga[q] * sigm(ga[q]) * ua[q]; gb[q] = gb[q] * sigm(gb[q]) * ub[q]; }
                st16(FF + t * DFF + col, pack8(ga, gb)); asm volatile("" ::: "memory"); }
    }
};
struct Gdn {
    static constexpr bool PERM = false; static constexpr int K = 2816; static constexpr size_t HSA = 128 * 5632, HSB = 128 * 5632;
    const char* A; const char* W; const float* X1; const float* MOD; float* OUT; float* SSQ;
    __device__ __forceinline__ unsigned offA(int R) const { return (unsigned)R * 5632u; }
    __device__ __forceinline__ unsigned offB(int R) const { return (unsigned)R * 5632u; }
    __device__ __forceinline__ void unit(int j, Unit& u) const { tile_of(j, 48, 4, u.pm, u.pn); u.A = A + (size_t)u.pm * 256 * 5632; u.B = W + (size_t)u.pn * 256 * 5632; }
    __device__ __forceinline__ void epi(EPI_ARGS) const {
        const int mi = u.pm < 16 ? 0 : (u.pm < 32 ? 1 : 2);
        const float* md = MOD + mi * 6144 + 5 * 1024;
        float ss[2][4];
#pragma unroll
        for (int ai = 0; ai < 2; ++ai)
#pragma unroll
            for (int m = 0; m < 4; ++m) ss[ai][m] = 0.f;
#pragma unroll
        for (int bj = 0; bj < 2; ++bj) { const int col = u.pn * 256 + 128 * bj + 32 * wc + 4 * fq;
            const f32x4 ga = *(const f32x4*)(md + col), gb = *(const f32x4*)(md + col + 16);
#pragma unroll
            for (int ai = 0; ai < 2; ++ai)
#pragma unroll
                for (int m = 0; m < 4; ++m) { const size_t t = (size_t)u.pm * 256 + 128 * ai + 64 * wr + 16 * m + fr;
                    const f32x4 x0 = *(const f32x4*)(X1 + t * 1024 + col) + ga * acc[ai][bj][m][0], x1 = *(const f32x4*)(X1 + t * 1024 + col + 16) + gb * acc[ai][bj][m][1];
                    st16f(OUT + t * 1024 + col, x0); st16f(OUT + t * 1024 + col + 16, x1);
                    ss[ai][m] += (x0[0] * x0[0] + x0[1] * x0[1]) + (x0[2] * x0[2] + x0[3] * x0[3]) + (x1[0] * x1[0] + x1[1] * x1[1]) + (x1[2] * x1[2] + x1[3] * x1[3]);
                    asm volatile("" ::: "memory"); } }
#pragma unroll
        for (int ai = 0; ai < 2; ++ai)
#pragma unroll
            for (int m = 0; m < 4; ++m) { float s = ss[ai][m]; s += __shfl_xor(s, 16); s += __shfl_xor(s, 32);
                if (fq == 0) st4f(SSQ + ((size_t)u.pm * 256 + 128 * ai + 64 * wr + 16 * m + fr) * 16 + u.pn * 4 + wc, s); }
    }
};

struct GF2 {
    static constexpr bool PERM = true; static constexpr int K = 256; static constexpr size_t HSA = 128 * 512, HSB = 128 * 512;
    const char* D1; const char* XS; const float* TW; bf16_t* Y1;
    __device__ __forceinline__ unsigned offA(int R) const { return (unsigned)R * 512u; }
    __device__ __forceinline__ unsigned offB(int R) const { return (unsigned)R * 512u; }
    __device__ __forceinline__ void unit(int j, Unit& u) const { u.pm = 0; u.pn = j; u.A = D1; u.B = XS + (size_t)j * 256 * 512; }
    __device__ __forceinline__ void epi(EPI_ARGS) const {
        const float* tw = TW; int fr2 = fr; asm volatile("" : "+s"(tw), "+v"(fr2));
#pragma unroll
        for (int bj = 0; bj < 2; ++bj) { const int combo = 4 * u.pn + 2 * bj + (wc >> 1), s = combo & 1, gq = 2 * (combo >> 1) + wr, la0 = 32 * (wc & 1) + 8 * fq;
#pragma unroll
            for (int m = 0; m < 4; ++m) { const int kb = 16 * m + fr2;
                const f32x4* tp = (const f32x4*)(tw + (size_t)(kb * 64 + la0) * 2);
                const f32x4 t0 = tp[0], t1 = tp[1], t2 = tp[2], t3 = tp[3];
                const f32x4 r0 = acc[0][bj][m][0], r1 = acc[0][bj][m][1], i0 = acc[1][bj][m][0], i1 = acc[1][bj][m][1];
                f32x4 pr0, pr1, pi0, pi1;
                pr0[0] = r0[0] * t0[0] + i0[0] * t0[1]; pi0[0] = i0[0] * t0[0] - r0[0] * t0[1];
                pr0[1] = r0[1] * t0[2] + i0[1] * t0[3]; pi0[1] = i0[1] * t0[2] - r0[1] * t0[3];
                pr0[2] = r0[2] * t1[0] + i0[2] * t1[1]; pi0[2] = i0[2] * t1[0] - r0[2] * t1[1];
                pr0[3] = r0[3] * t1[2] + i0[3] * t1[3]; pi0[3] = i0[3] * t1[2] - r0[3] * t1[3];
                pr1[0] = r1[0] * t2[0] + i1[0] * t2[1]; pi1[0] = i1[0] * t2[0] - r1[0] * t2[1];
                pr1[1] = r1[1] * t2[2] + i1[1] * t2[3]; pi1[1] = i1[1] * t2[2] - r1[1] * t2[3];
                pr1[2] = r1[2] * t3[0] + i1[2] * t3[1]; pi1[2] = i1[2] * t3[0] - r1[2] * t3[1];
                pr1[3] = r1[3] * t3[2] + i1[3] * t3[3]; pi1[3] = i1[3] * t3[2] - r1[3] * t3[3];
                const size_t base = ((((size_t)(s * 512 + gq) * 16 + (kb >> 2)) * 4 + (kb & 3)) * 2) * 64 + la0;
                st16(Y1 + base, pack8(pr0, pr1)); st16(Y1 + base + 64, pack8(pi0, pi1)); asm volatile("" ::: "memory"); } }
    }
};
struct GSA {
    static constexpr bool PERM = false; static constexpr int K = 256; static constexpr size_t HSA = 128 * 1024, HSB = 128 * 512;
    const char* UH; const char* SF; float* SST;
    __device__ __forceinline__ unsigned offA(int R) const { return (unsigned)R * 1024u; }
    __device__ __forceinline__ unsigned offB(int R) const { return (unsigned)R * 512u; }
    __device__ __forceinline__ void unit(int j, Unit& u) const { u.pn = j / 3; u.pm = j - 3 * u.pn; u.A = UH + (size_t)(u.pn * NCH + 256 * u.pm) * 1024; u.B = SF + (size_t)u.pn * 256 * 512; }
    __device__ __forceinline__ void epi(EPI_ARGS) const {
#pragma unroll
        for (int ai = 0; ai < 2; ++ai)
#pragma unroll
            for (int m = 0; m < 4; ++m) { const int chunk = 256 * u.pm + 128 * ai + 64 * wr + 16 * m + fr;
#pragma unroll
                for (int bj = 0; bj < 2; ++bj) { float* d = SST + (size_t)(u.pn * NCH + chunk) * 256 + 128 * bj + 32 * wc + 4 * fq;
                    st16f(d, acc[ai][bj][m][0]); st16f(d + 16, acc[ai][bj][m][1]); } }
    }
};
struct GF3s {
    static constexpr bool PERM = true; static constexpr int K = 512; static constexpr size_t HSA = 128 * 1024, HSB = 8 * 1024;
    const char* D2; const char* Y1; bf16_t* YF;
    __device__ __forceinline__ unsigned offA(int R) const { return (unsigned)R * 1024u; }
    __device__ __forceinline__ unsigned offB(int R) const { return (unsigned)((R & 15) * 16 + (R >> 4)) * 1024u; }
    __device__ __forceinline__ void unit(int j, Unit& u) const { u.pm = j >> 5; u.pn = 16 * (j & 31); u.A = D2; u.B = Y1 + (size_t)((u.pm * 512 + u.pn) * 16) * 1024; }
    __device__ __forceinline__ void epi(EPI_ARGS) const {
#pragma unroll
        for (int ai = 0; ai < 2; ++ai)
#pragma unroll
            for (int m = 0; m < 4; ++m) { const int mu2 = 2 * ai + wr, ka = 16 * m + fr;
#pragma unroll
                for (int bj = 0; bj < 2; ++bj) { const int c0 = 128 * bj + 32 * wc + 8 * fq, kap = c0 >> 4, qi0 = c0 & 15;
                    const int k = 64 * ka + 4 * kap + mu2;
                    st16(YF + (size_t)(NTP + 4096 * u.pm + k) * 512 + u.pn + qi0, pack8(acc[ai][bj][m][0], acc[ai][bj][m][1])); } }
    }
};
struct GF3p {
    static constexpr bool PERM = true; static constexpr int K = 512; static constexpr size_t HSA = 128 * 1024, HSB = 128 * 1024;
    const char* DP; const char* XP; bf16_t* YF;
    __device__ __forceinline__ unsigned offA(int R) const { return (unsigned)R * 1024u; }
    __device__ __forceinline__ unsigned offB(int R) const { return (unsigned)R * 1024u; }
    __device__ __forceinline__ void unit(int j, Unit& u) const { u.pm = 0; u.pn = j; u.A = DP; u.B = XP + (size_t)j * 256 * 1024; }
    __device__ __forceinline__ void epi(EPI_ARGS) const {
#pragma unroll
        for (int ai = 0; ai < 2; ++ai)
#pragma unroll
            for (int m = 0; m < 4; ++m) { const int k = 128 * ai + 64 * wr + 16 * m + fr;
#pragma unroll
                for (int bj = 0; bj < 2; ++bj) { const int xr = 256 * u.pn + 128 * bj + 32 * wc + 8 * fq, b = xr >> 9, gq = xr & 511;
                    st16(YF + (size_t)(256 * b + k) * 512 + gq, pack8(acc[ai][bj][m][0], acc[ai][bj][m][1])); } }
    }
};
struct GSC {
    static constexpr bool PERM = true; static constexpr int K = 512; static constexpr size_t HSA = 128 * 1024, HSB = 128 * 1024;
    const char* UH; const char* ME; bf16_t* ZB;
    __device__ __forceinline__ unsigned offA(int R) const { return (unsigned)R * 1024u; }
    __device__ __forceinline__ unsigned offB(int R) const { return (unsigned)R * 1024u; }
    __device__ __forceinline__ void unit(int j, Unit& u) const { u.pn = j / 3; u.pm = j - 3 * u.pn; u.A = UH + (size_t)(u.pn * NCH + 256 * u.pm) * 1024; u.B = ME + (size_t)u.pn * 256 * 1024; }
    __device__ __forceinline__ void epi(EPI_ARGS) const {
#pragma unroll
        for (int ai = 0; ai < 2; ++ai)
#pragma unroll
            for (int m = 0; m < 4; ++m) { const int chunk = 256 * u.pm + 128 * ai + 64 * wr + 16 * m + fr;
#pragma unroll
                for (int bj = 0; bj < 2; ++bj) { const int c0 = 128 * bj + 32 * wc + 8 * fq, i = c0 >> 4, h0 = c0 & 15;
                    f32x4 a = acc[ai][bj][m][0], b = acc[ai][bj][m][1];
#pragma unroll
                    for (int q = 0; q < 4; ++q) { a[q] = gelu_tanh(a[q]); b[q] = gelu_tanh(b[q]); }
                    st16(ZB + (size_t)(16 * chunk + i) * 512 + 16 * u.pn + h0, pack8(a, b)); } }
    }
};

struct Params {
    const float* in[27];
    float* out;
    unsigned char* wsp;
    int never; int pad;
};

__device__ __forceinline__ void transpose_item(const float* W, int ldw, int n0, int k0, bf16_t* WT, int drow, int Kd, LAS float* scr, int lane) {
#pragma unroll 8
    for (int i = 0; i < 32; ++i) { const int kk = 2 * i + (lane >> 5); scr[kk * 33 + (lane & 31)] = W[(size_t)(k0 + kk) * ldw + n0 + (lane & 31)]; }
    asm volatile("s_waitcnt lgkmcnt(0)" ::: "memory");
    const int c = lane & 7;
#pragma unroll
    for (int jj = 0; jj < 4; ++jj) { const int n = (lane >> 3) + 8 * jj; const LAS float* s = scr + (8 * c) * 33 + n;
        u32x4 o; o.x = cvt_pk_bf16(s[0 * 33], s[1 * 33]); o.y = cvt_pk_bf16(s[2 * 33], s[3 * 33]); o.z = cvt_pk_bf16(s[4 * 33], s[5 * 33]); o.w = cvt_pk_bf16(s[6 * 33], s[7 * 33]);
        st16(WT + (size_t)(drow + n) * Kd + k0 + 8 * c, o); }
    asm volatile("s_waitcnt lgkmcnt(0)" ::: "memory");
}

__global__ void __launch_bounds__(512, 2) fwd_kernel(Params P) {
    extern __shared__ __attribute__((aligned(16))) unsigned char lds_raw[];
    LAS unsigned char* lds = (LAS unsigned char*)lds_raw;
    cg::grid_group grid = cg::this_grid();
    if (P.never) grid.sync();
    if (threadIdx.x < 2) ((volatile LAS unsigned*)(lds + 8 * HTB + 16384 - 16))[threadIdx.x] = 0u;
    __syncthreads();
    (void)xcd_barrier_post((unsigned*)(P.wsp + WS_BAR), (volatile LAS unsigned*)(lds + 8 * HTB + 16384 - 16));
#define GRID_SYNC1() do { asm volatile("s_waitcnt vmcnt(0) lgkmcnt(0)" ::: "memory"); XcdBarrier _xb; _xb.bar = (unsigned*)(P.wsp + WS_BAR); _xb.x = xb_xcc_id(); _xb.st = (volatile LAS unsigned*)(lds + 8 * HTB + 16384 - 16); xcd_barrier(_xb); } while (0)
#ifndef REP_SYNC
#define REP_SYNC 1
#endif
#define GRID_SYNC() do { for (int _r = 0; _r < REP_SYNC; ++_r) GRID_SYNC1(); } while (0)
#define FRESH_IDS int tid = threadIdx.x; asm volatile("" : "+v"(tid)); const int lane = tid & 63, wave = __builtin_amdgcn_readfirstlane(tid >> 6); \
    const int gw = blockIdx.x * 8 + wave, NGW = gridDim.x * 8; (void)lane; (void)gw; (void)NGW;
#define ws (P.wsp)
#define x_prompt (P.in[0])
#define x_sample (P.in[1])
#define state_s5 (P.in[2])
#define cvec (P.in[3])
#define c_ctx (P.in[4])
#define norm1_g (P.in[5])
#define norm2_g (P.in[6])
#define w_ada (P.in[7])
#define b_ada (P.in[8])
#define w_in (P.in[9])
#define lam_re (P.in[10])
#define lam_im (P.in[11])
#define log_step (P.in[12])
#define b_re (P.in[13])
#define b_im (P.in[14])
#define c_re (P.in[15])
#define c_im (P.in[16])
#define s5_d (P.in[17])
#define w_glu (P.in[18])
#define b_glu (P.in[19])
#define w_ps (P.in[20])
#define w_pf (P.in[21])
#define w_o (P.in[22])
#define w_g (P.in[23])
#define w_u (P.in[24])
#define w_d (P.in[25])
#define fin_g (P.in[26])
#define CTL ((unsigned*)(ws + WS_CTL))
#define MOD ((float*)(ws + WS_MOD))
#define SVGU ((float*)(ws + WS_SVGU))
#define MODP ((float*)(ws + WS_MODP))
#define SSQ2 ((float*)(ws + WS_SSQ2))
#define SSQ3 ((float*)(ws + WS_SSQ3))
#define W1T ((bf16_t*)(ws + WS_W1T))
#define WFT ((bf16_t*)(ws + WS_WFT))
#define WGLU ((bf16_t*)(ws + WS_WGLU))
#define WPS ((bf16_t*)(ws + WS_WPS))
#define WPF ((bf16_t*)(ws + WS_WPF))
#define WO ((bf16_t*)(ws + WS_WO))
#define WGU ((bf16_t*)(ws + WS_WGU))
#define WD ((bf16_t*)(ws + WS_WD))
#define SG ((bf16_t*)(ws + WS_R1))
#define X1 ((float*)(ws + WS_R1))
#define UH ((bf16_t*)(ws + WS_R3))
#define A2B ((bf16_t*)(ws + WS_R3))
#define T1 ((float*)(ws + WS_R3))
#define XS ((bf16_t*)(ws + WS_R4))
#define XP ((bf16_t*)(ws + WS_XP))
#define FF ((bf16_t*)(ws + WS_R4))
#define ZB ((bf16_t*)(ws + WS_R5))
#define YS ((bf16_t*)(ws + WS_YS))
#define YF ((bf16_t*)(ws + WS_YF))
#define HB ((bf16_t*)(ws + WS_R2))
#define YACC ((float*)(ws + WS_R2))
#define MB ((bf16_t*)(ws + WS_R2))
#define SST ((float*)(ws + WS_R2))
#define Y1B ((bf16_t*)(ws + WS_R5))
#define SFM ((bf16_t*)(ws + WS_SF))
#define MEM ((bf16_t*)(ws + WS_ME))
#define KKM ((float*)(ws + WS_KK))
#define A16M ((float*)(ws + WS_A16))
#define D1M ((bf16_t*)(ws + WS_D1))
#define D2M ((bf16_t*)(ws + WS_D2))
#define DPM ((bf16_t*)(ws + WS_DP))
#define TWM ((float*)(ws + WS_TW))
#define OUT (P.out)

    {
        FRESH_IDS
        if (blockIdx.x < 128) {
            LAS float* tile = (LAS float*)lds;
            LAS float* cs = tile + 32 * 132; LAS float* sn = cs + 128;
            const int gg = blockIdx.x >> 5, k0 = 32 * (blockIdx.x & 31);
            for (int idx = tid; idx < 32 * 32; idx += 512) { const int row = idx >> 5, c4 = idx & 31;
                const f32x4 v = *(const f32x4*)(w_in + (size_t)(k0 + row) * 3072 + 512 + 128 * gg + 4 * c4);
                *(LAS f32x4*)(tile + row * 132 + 4 * c4) = v; }
            if (tid < 128) { float s, c; sincos_frac(tid, 128, s, c); cs[tid] = c * 0.08838834764831845f; sn[tid] = s * 0.08838834764831845f; }
            __syncthreads();
            const int n = tid & 255, part = n >> 7, q = n & 127, kh = tid >> 8;
            float a[16];
#pragma unroll
            for (int i = 0; i < 16; ++i) a[i] = 0.f;
            const LAS float* tb = part ? sn : cs;
            for (int c = 0; c < 128; c += 4) {
                const float r0 = tb[(q * c) & 127], r1 = tb[(q * (c + 1)) & 127], r2 = tb[(q * (c + 2)) & 127], r3 = tb[(q * (c + 3)) & 127];
#pragma unroll
                for (int i = 0; i < 16; ++i) { const f32x4 w = *(const LAS f32x4*)(tile + (16 * kh + i) * 132 + c); a[i] += (w[0] * r0 + w[1] * r1) + (w[2] * r2 + w[3] * r3); }
            }
            bf16_t* dst = WFT + (size_t)(gg * 256 + n) * 1024 + k0 + 16 * kh;
            u32x4 o0, o1; o0.x = cvt_pk_bf16(a[0], a[1]); o0.y = cvt_pk_bf16(a[2], a[3]); o0.z = cvt_pk_bf16(a[4], a[5]); o0.w = cvt_pk_bf16(a[6], a[7]);
            o1.x = cvt_pk_bf16(a[8], a[9]); o1.y = cvt_pk_bf16(a[10], a[11]); o1.z = cvt_pk_bf16(a[12], a[13]); o1.w = cvt_pk_bf16(a[14], a[15]);
            st16(dst, o0); st16(dst + 8, o1);
            __syncthreads();
        }
        else if (blockIdx.x < 192) {
            LAS float* Wre = (LAS float*)lds; LAS float* Wim = Wre + 16384;
            LAS float* Cre = Wim + 16384; LAS float* Cim = Cre + 16 * 65;
            const int td = blockIdx.x - 128, gg = td >> 1, d = td & 1;
            {
                const int p = tid & 63, hq = tid >> 6, pi = (d * 32 + gg) * 64 + p;
                const float lr = lam_re[pi], li = lam_im[pi], step = __expf(log_step[d * 32 + gg]);
                double sd, cd; sincos_d((double)(li * step), sd, cd);
                const float mag = __expf(lr * step), are = mag * (float)cd, aim = mag * (float)sd;
                const float nr = are - 1.0f, ni = aim, den = lr * lr + li * li, fr_ = (nr * lr + ni * li) / den, fi_ = (ni * lr - nr * li) / den;
                float wr_[2], wi_[2], cr_[2], ci_[2];
#pragma unroll
                for (int e = 0; e < 2; ++e) { const int h = 2 * hq + e; const float br = b_re[(size_t)pi * 16 + h], bi = b_im[(size_t)pi * 16 + h];
                    wr_[e] = fr_ * br - fi_ * bi; wi_[e] = fr_ * bi + fi_ * br;
                    cr_[e] = c_re[((size_t)(d * 32 + gg) * 16 + h) * 64 + p]; ci_[e] = c_im[((size_t)(d * 32 + gg) * 16 + h) * 64 + p];
                    Cre[h * 65 + p] = cr_[e]; Cim[h * 65 + p] = ci_[e]; }
                float pr = are, pim = aim;
#pragma unroll
                for (int m = 0; m < 16; ++m) {
#pragma unroll
                    for (int e = 0; e < 2; ++e) { const int h = 2 * hq + e; Wre[(m * 64 + p) * 16 + h] = wr_[e]; Wim[(m * 64 + p) * 16 + h] = wi_[e];
                        const float nwr = are * wr_[e] - aim * wi_[e], nwi = are * wi_[e] + aim * wr_[e]; wr_[e] = nwr; wi_[e] = nwi;
                        const float vr = cr_[e] * pr - ci_[e] * pim, vi = cr_[e] * pim + ci_[e] * pr;
                        const int irow = d ? 15 - m : m;
                        float* dst = (float*)(MEM + ((size_t)(gg * 256 + 16 * irow + h) * 512 + 256 + d * 128 + 2 * p));
                        st4f(dst, __uint_as_float(cvt_pk_bf16(vr, -vi))); }
                    if (m == 15 && hq == 0) { float* a16 = A16M + (size_t)((gg * 2 + d) * 64 + p) * 2; st4f(a16, pr); st4f(a16 + 1, pim); }
                    const float npr = pr * are - pim * aim, npi = pr * aim + pim * are; pr = npr; pim = npi;
                }
            }
            __syncthreads();
            {
                const int nl = tid >> 2, p = nl >> 1, ri = nl & 1, qt = tid & 3;
                const LAS float* Wsrc = ri ? Wim : Wre;
#pragma unroll
                for (int e = 0; e < 4; ++e) { const int jj = 4 * qt + e, m = d ? jj : 15 - jj;
                    const LAS f32x4* wp = (const LAS f32x4*)(Wsrc + (m * 64 + p) * 16);
                    bf16_t* dst = SFM + ((size_t)(gg * 256 + d * 128 + nl) * 256 + 16 * jj);
                    st16(dst, pack8(wp[0], wp[1])); st16(dst + 8, pack8(wp[2], wp[3])); }
            }
            {
                const int m = tid >> 5, hp = (tid >> 1) & 15, hh = (tid & 1) * 8;
                f32x4 a0 = {0.f, 0.f, 0.f, 0.f}, a1 = a0;
                for (int p = 0; p < 64; ++p) { const float cr = Cre[hp * 65 + p], ci = Cim[hp * 65 + p];
                    const LAS f32x4* wrp = (const LAS f32x4*)(Wre + (m * 64 + p) * 16 + hh); const LAS f32x4* wip = (const LAS f32x4*)(Wim + (m * 64 + p) * 16 + hh);
                    a0 += wrp[0] * cr - wip[0] * ci; a1 += wrp[1] * cr - wip[1] * ci; }
                float* dst = KKM + ((size_t)((gg * 2 + d) * 16 + m) * 256 + hp * 16 + hh);
                st16f(dst, a0); st16f(dst + 4, a1);
            }
            __syncthreads();
        }
        else {
            const int gt = (blockIdx.x - 192) * 512 + tid, ngt = (gridDim.x - 192) * 512;
            for (int tk = gt; tk < 8192 + 16384 + 16384 + 2048; tk += ngt) {
                float v[8];
                if (tk < 8192) {
                    const int r = tk >> 5, k0 = (tk & 31) * 8, pp = r >> 7, mup = (r >> 6) & 1, kb = r & 63, mu = k0 >> 7, part = (k0 >> 6) & 1, lb0 = k0 & 63;
#pragma unroll
                    for (int e = 0; e < 8; ++e) { float s, c; sincos_frac(kb * (lb0 + e), 64, s, c);
                        const float val = (pp == 0) ? (part == 0 ? c : -s) : (part == 0 ? -s : -c); v[e] = (mu == mup) ? val * 0.125f : 0.f; }
                    st16(D1M + (size_t)r * 256 + k0, pack8((f32x4){v[0], v[1], v[2], v[3]}, (f32x4){v[4], v[5], v[6], v[7]}));
                } else if (tk < 8192 + 16384) {
                    const int t2 = tk - 8192, r = t2 >> 6, k0 = (t2 & 63) * 8, mu2 = r >> 6, ka = r & 63, mu2p = k0 >> 7, part = (k0 >> 6) & 1, la0 = k0 & 63;
#pragma unroll
                    for (int e = 0; e < 8; ++e) { float s, c; sincos_frac(ka * (la0 + e), 64, s, c); v[e] = (mu2 == mu2p) ? (part == 0 ? c : s) * 0.125f : 0.f; }
                    st16(D2M + (size_t)r * 512 + k0, pack8((f32x4){v[0], v[1], v[2], v[3]}, (f32x4){v[4], v[5], v[6], v[7]}));
                } else if (tk < 8192 + 32768) {
                    const int t2 = tk - 8192 - 16384, r = t2 >> 6, k0 = (t2 & 63) * 8, part = k0 >> 8, l0 = k0 & 255;
#pragma unroll
                    for (int e = 0; e < 8; ++e) { float s, c; sincos_frac(r * (l0 + e), 256, s, c); v[e] = (part == 0 ? c : -s) * 0.0625f; }
                    st16(DPM + (size_t)r * 512 + k0, pack8((f32x4){v[0], v[1], v[2], v[3]}, (f32x4){v[4], v[5], v[6], v[7]}));
                } else {
                    const int t2 = tk - 8192 - 32768, kb = t2 >> 5, la0 = (t2 & 31) * 2;
                    float s0, c0, s1, c1; sincos_frac(kb * la0, 4096, s0, c0); sincos_frac(kb * (la0 + 1), 4096, s1, c1);
                    st16f(TWM + (size_t)(kb * 64 + la0) * 2, (f32x4){c0, s0, c1, s1});
                }
            }
        }
        for (int tk = gw; tk < 768; tk += NGW) {
            const int cgp = tk % 24, kc = tk / 24;
            float sl0 = 0.f, sl1 = 0.f, sl2 = 0.f;
            if (lane < 32) { const int k = kc * 32 + lane; const float a = c_ctx[k], b = cvec[k], c = cvec[1024 + k]; sl0 = a * sigm(a); sl1 = b * sigm(b); sl2 = c * sigm(c); }
            f32x4 a0 = {0.f, 0.f, 0.f, 0.f}, a1 = a0, a2 = a0;
            const float* wp = w_ada + (size_t)(kc * 32) * 6144 + cgp * 256 + lane * 4;
#pragma unroll 8
            for (int kk = 0; kk < 32; ++kk) { const f32x4 w = *(const f32x4*)(wp + (size_t)kk * 6144);
                const float s0 = __shfl(sl0, kk), s1 = __shfl(sl1, kk), s2 = __shfl(sl2, kk);
                a0 += w * s0; a1 += w * s1; a2 += w * s2; }
            float* pp = MODP + (size_t)kc * 3 * 6144 + cgp * 256 + lane * 4;
            st16f(pp, a0); st16f(pp + 6144, a1); st16f(pp + 2 * 6144, a2);
        }
    }
    GRID_SYNC();
    {
        FRESH_IDS
        for (int tk = gw; tk < 24; tk += NGW) {
            const int col = tk * 256 + lane * 4;
            const f32x4 bv = *(const f32x4*)(b_ada + col);
            f32x4 r0 = bv, r1 = bv, r2 = bv;
            for (int k2 = 0; k2 < 32; ++k2) { const float* q = MODP + (size_t)k2 * 3 * 6144 + col;
                r0 += *(const f32x4*)q; r1 += *(const f32x4*)(q + 6144); r2 += *(const f32x4*)(q + 2 * 6144); }
            st16f(MOD + col, r0); st16f(MOD + 6144 + col, r1); st16f(MOD + 2 * 6144 + col, r2);
        }
        LAS float* scr = (LAS float*)(lds + 32768 + wave * 8704);
        for (int it = gw; it < 6656; it += NGW) {
            int r = it;
            if (r < 256) { const int kb = r / 16, nb = r % 16; transpose_item(w_in, 3072, 32 * nb, 64 * kb, W1T, 32 * nb, 1024, scr, lane); continue; } r -= 256;
            if (r < 1024) { const int kb = r / 64, nb = r % 64; transpose_item(w_in, 3072, 1024 + 32 * nb, 64 * kb, W1T, 512 + 32 * nb, 1024, scr, lane); continue; } r -= 1024;
            if (r < 128) { const int kb = r / 16, nb = r % 16; transpose_item(w_glu, 512, 32 * nb, 64 * kb, WGLU, 32 * nb, 512, scr, lane); continue; } r -= 128;
            if (r < 256) { const int kb = r / 32, nb = r % 32; transpose_item(w_ps, 1024, 32 * nb, 64 * kb, WPS, 32 * nb, 512, scr, lane); continue; } r -= 256;
            if (r < 256) { const int kb = r / 32, nb = r % 32; transpose_item(w_pf, 1024, 32 * nb, 64 * kb, WPF, 32 * nb, 512, scr, lane); continue; } r -= 256;
            if (r < 512) { const int kb = r / 32, nb = r % 32; transpose_item(w_o, 1024, 32 * nb, 64 * kb, WO, 32 * nb, 1024, scr, lane); continue; } r -= 512;
            if (r < 1408) { const int kb = r / 88, nb = r % 88, n0 = 32 * nb; transpose_item(w_g, 2816, n0, 64 * kb, WGU, 256 * (n0 >> 7) + (n0 & 127), 1024, scr, lane); continue; } r -= 1408;
            if (r < 1408) { const int kb = r / 88, nb = r % 88, n0 = 32 * nb; transpose_item(w_u, 2816, n0, 64 * kb, WGU, 256 * (n0 >> 7) + 128 + (n0 & 127), 1024, scr, lane); continue; } r -= 1408;
            { const int kb = r / 32, nb = r % 32; transpose_item(w_d, 1024, 32 * nb, 64 * kb, WD, 32 * nb, 2816, scr, lane); }
        }
    }
    GRID_SYNC();
    {
        FRESH_IDS
        for (int t = gw; t < NT; t += NGW) {
            const float* xr = t < NTP ? x_prompt + (size_t)t * 1024 : x_sample + (size_t)(t - NTP) * 1024;
            const int mi = t < NTP ? 0 : (t < NTP + 4096 ? 1 : 2);
            const float* md = MOD + mi * 6144;
            f32x4 v[4]; float s = 0.f;
#pragma unroll
            for (int jx = 0; jx < 4; ++jx) { v[jx] = *(const f32x4*)(xr + 8 * lane + 512 * (jx >> 1) + 4 * (jx & 1)); s += (v[jx][0] * v[jx][0] + v[jx][1] * v[jx][1]) + (v[jx][2] * v[jx][2] + v[jx][3] * v[jx][3]); }
            const float r = 1.0f / sqrtf(wave_sum(s) * (1.0f / 1024.0f) + EPS);
            f32x4 h[4];
#pragma unroll
            for (int jx = 0; jx < 4; ++jx) { const int col = 8 * lane + 512 * (jx >> 1) + 4 * (jx & 1);
                const f32x4 gs = *(const f32x4*)(norm1_g + col) * (*(const f32x4*)(md + 1024 + col) + 1.0f), sh = *(const f32x4*)(md + col);
                h[jx] = v[jx] * r * gs + sh; }
            st16(HB + (size_t)t * 1024 + 8 * lane, pack8(h[0], h[1])); st16(HB + (size_t)t * 1024 + 512 + 8 * lane, pack8(h[2], h[3]));
        }
        for (int idx = blockIdx.x * 512 + tid; idx < 131072; idx += gridDim.x * 512) {
            const int gg = idx >> 12, r = (idx >> 4) & 255, jj = idx & 15, i = r >> 4, hp = r & 15;
            f32x4 v0 = {0.f, 0.f, 0.f, 0.f}, v1 = v0, v2 = v0, v3 = v0;
            if (jj <= i) { const f32x4* kp = (const f32x4*)(KKM + ((size_t)((gg * 2 + 0) * 16 + (i - jj)) * 256 + hp * 16)); v0 += kp[0]; v1 += kp[1]; v2 += kp[2]; v3 += kp[3]; }
            if (jj >= i) { const f32x4* kp = (const f32x4*)(KKM + ((size_t)((gg * 2 + 1) * 16 + (jj - i)) * 256 + hp * 16)); v0 += kp[0]; v1 += kp[1]; v2 += kp[2]; v3 += kp[3]; }
            if (jj == i) { const float dv = s5_d[16 * gg + hp];
#pragma unroll
                for (int e = 0; e < 4; ++e) { v0[e] += (hp == e) ? dv : 0.f; v1[e] += (hp == 4 + e) ? dv : 0.f; v2[e] += (hp == 8 + e) ? dv : 0.f; v3[e] += (hp == 12 + e) ? dv : 0.f; } }
            bf16_t* dst = MEM + ((size_t)(gg * 256 + r) * 512 + 16 * jj);
            st16(dst, pack8(v0, v1)); st16(dst + 8, pack8(v2, v3));
        }
        for (int n = gw; n < 5632; n += NGW) {
            const u32x4 w0 = *(const u32x4*)(WGU + (size_t)n * 1024 + 16 * lane), w1 = *(const u32x4*)(WGU + (size_t)n * 1024 + 16 * lane + 8);
            f32x4 wa, wb, wc4, wd; unpack8(w0, wa, wb); unpack8(w1, wc4, wd);
#pragma unroll
            for (int mi = 0; mi < 3; ++mi) { const float* sh = MOD + mi * 6144 + 3 * 1024 + 16 * lane;
                const f32x4 s0 = *(const f32x4*)(sh), s1 = *(const f32x4*)(sh + 4), s2 = *(const f32x4*)(sh + 8), s3 = *(const f32x4*)(sh + 12);
                const f32x4 p = wa * s0 + wb * s1 + wc4 * s2 + wd * s3;
                const float d = wave_sum((p[0] + p[1]) + (p[2] + p[3]));
                if (lane == 0) st4f(SVGU + mi * 5632 + n, d); }
        }
    }
    GRID_SYNC();
#if DBG_STOP == 2
    { FRESH_IDS
      for (size_t i = (size_t)blockIdx.x * 512 + tid; i < (size_t)NT * 1024; i += (size_t)gridDim.x * 512) { const size_t c = i & 1023; OUT[i] = bf2f(HB[i]) + 0.25f * (bf2f(W1T[i % (2560 * 1024)]) + bf2f(WFT[i % (1024 * 1024)]) + bf2f(WGU[i % (5632 * 1024)]) + bf2f(WD[i % (2816 * 1024)])) + MOD[i % 18432]; (void)c; }
      for (size_t i = (size_t)blockIdx.x * 512 + tid; i < 131072; i += (size_t)gridDim.x * 512) { OUT[(size_t)NT * 1024 + i] = SVGU[i % 16896] + bf2f(WGLU[i]) + bf2f(WPS[i]) + bf2f(WPF[i]) + bf2f(WO[i]); }
      return; }
#endif
    { G1a g{(const char*)HB, (const char*)W1T, UH, SG}; gemm_phase(lds, g, 0, 480); }
    { G1b g{(const char*)HB, (const char*)WFT, XS}; gemm_phase(lds, g, 480, 128); }
    { G1c g{(const char*)HB, (const char*)WFT, XP}; gemm_phase(lds, g, 608, 64); }
    GRID_SYNC();
#if DBG_STOP == 1
    { FRESH_IDS
      for (size_t i = (size_t)blockIdx.x * 512 + tid; i < (size_t)NT * 1024; i += (size_t)gridDim.x * 512) { const size_t t = i >> 10, c = i & 1023; OUT[i] = bf2f(SG[t * 2048 + c]) + bf2f(SG[t * 2048 + 1024 + c]); }
      for (size_t i = (size_t)blockIdx.x * 512 + tid; i < 131072; i += (size_t)gridDim.x * 512) { float a = 0.f; for (int r = 0; r < 64; ++r) a += bf2f(XS[i * 64 + r]) + bf2f(XP[i * 32 + (r & 31)]); const size_t u = i * 48; const size_t row = u >> 8, cc = u & 255; a += bf2f(UH[row * 512 + cc]); OUT[(size_t)NT * 1024 + i] = a; }
      return; }
#endif
    { GF2 g{(const char*)D1M, (const char*)XS, TWM, Y1B}; gemm_phase(lds, g, 0, 128); }
    { GSA g{(const char*)UH, (const char*)SFM, SST}; gemm_phase(lds, g, 128, 96); }
    GRID_SYNC();
    { GF3s g{(const char*)D2M, (const char*)Y1B, YF}; gemm_phase(lds, g, 0, 64); }
    { GF3p g{(const char*)DPM, (const char*)XP, YF}; gemm_phase(lds, g, 64, 32); }
    if (blockIdx.x >= 96) {
        FRESH_IDS
        const int nw = (gridDim.x - 96) * 8;
        for (int tk = (blockIdx.x - 96) * 8 + wave; tk < 1152; tk += nw) {
            int gg, d, nc, cbase, sidx; bool smp;
            if (tk < 128) { smp = true; sidx = tk >> 6; gg = (tk >> 1) & 31; d = tk & 1; nc = 256; cbase = 256 + 256 * sidx; }
            else { const int t2 = tk - 128; smp = false; sidx = t2 >> 6; gg = (t2 >> 1) & 31; d = t2 & 1; nc = 16; cbase = 16 * sidx; }
            const f32x2 a16 = *(const f32x2*)(A16M + (size_t)((gg * 2 + d) * 64 + lane) * 2);
            float hre = 0.f, him = 0.f;
            if (smp) { hre = state_s5[(((size_t)sidx * 2 + d) * 2 + 0) * 2048 + gg * 64 + lane]; him = state_s5[(((size_t)sidx * 2 + d) * 2 + 1) * 2048 + gg * 64 + lane]; }
            const float* sp = SST + (size_t)(gg * NCH + cbase) * 256 + d * 128 + 2 * lane;
            bf16_t* hp = UH + (size_t)(gg * NCH + cbase) * 512 + 256 + d * 128 + 2 * lane;
            const int c0 = d ? nc - 1 : 0, cs = d ? -1 : 1;
            f32x2 cur[16], nxt[16];
#pragma unroll
            for (int e = 0; e < 16; ++e) cur[e] = *(const f32x2*)(sp + (ptrdiff_t)(c0 + cs * e) * 256);
            for (int cb = 0; cb < nc; cb += 16) {
                if (cb + 16 < nc) {
#pragma unroll
                    for (int e = 0; e < 16; ++e) nxt[e] = *(const f32x2*)(sp + (ptrdiff_t)(c0 + cs * (cb + 16 + e)) * 256);
                }
#pragma unroll
                for (int e = 0; e < 16; ++e) { const int c = c0 + cs * (cb + e);
                    st4f((float*)(hp + (ptrdiff_t)c * 512), __uint_as_float(cvt_pk_bf16(hre, him)));
                    const float nr = a16[0] * hre - a16[1] * him + cur[e][0], ni = a16[0] * him + a16[1] * hre + cur[e][1]; hre = nr; him = ni; }
#pragma unroll
                for (int e = 0; e < 16; ++e) cur[e] = nxt[e];
            }
            if (!smp) { float* ns = OUT + (size_t)NT * 1024 + (((size_t)sidx * 2 + d) * 2) * 2048 + gg * 64 + lane; ns[0] = hre; ns[2048] = him; }
        }
    }
    GRID_SYNC();
    { GSC g{(const char*)UH, (const char*)MEM, ZB}; gemm_phase(lds, g, 0, 96); }
    GRID_SYNC();
    { Gglu g{(const char*)ZB, (const char*)WGLU, b_glu, YS}; gemm_phase(lds, g, 0, 96); }
    GRID_SYNC();
    { Gps g{(const char*)YS, (const char*)WPS, SG, T1}; gemm_phase(lds, g, 0, 192); }
    { Gpf g{(const char*)YF, (const char*)WPF, SG, T1, MB}; gemm_phase(lds, g, 0, 192); }
    GRID_SYNC();
    { Gwo g{(const char*)MB, (const char*)WO, x_prompt, x_sample, MOD, norm2_g, X1, A2B, SSQ2}; gemm_phase(lds, g, 0, 192); }
    GRID_SYNC();
    { Ggu g{(const char*)A2B, (const char*)WGU, SSQ2, SVGU, FF}; gemm_phase(lds, g, 0, 1056); }
    GRID_SYNC();
    { Gdn g{(const char*)FF, (const char*)WD, X1, MOD, OUT, SSQ3}; gemm_phase(lds, g, 0, 192); }
    GRID_SYNC();
    { FRESH_IDS
    for (int t = gw; t < NT; t += NGW) {
        const f32x4* sp = (const f32x4*)(SSQ3 + (size_t)t * 16); const f32x4 q4 = (sp[0] + sp[1]) + (sp[2] + sp[3]);
        const float r = 1.0f / sqrtf(((q4[0] + q4[1]) + (q4[2] + q4[3])) * (1.0f / 1024.0f) + EPS);
        float* row = OUT + (size_t)t * 1024;
#pragma unroll
        for (int jx = 0; jx < 4; ++jx) { const int col = 4 * lane + 256 * jx; *(f32x4*)(row + col) = *(const f32x4*)(row + col) * r * *(const f32x4*)(fin_g + col); }
    } }
}

#undef ws
#undef OUT
constexpr int LDS_BYTES = 8 * HTB + 16384;

extern "C" void kernel_launch(void* const* d_in, const int* in_sizes, int n_in, void* d_out, int out_size, void* d_ws, size_t ws_size, hipStream_t stream) {
    static int grid = 0;
    if (grid == 0) {
        int dev = 0, cus = 0, per_cu = 0;
        hipGetDevice(&dev);
        hipDeviceGetAttribute(&cus, hipDeviceAttributeMultiprocessorCount, dev);
        if (hipFuncSetAttribute((const void*)fwd_kernel, hipFuncAttributeMaxDynamicSharedMemorySize, LDS_BYTES) != hipSuccess) fprintf(stderr, "hipFuncSetAttribute failed\n");
        if (hipOccupancyMaxActiveBlocksPerMultiprocessor(&per_cu, (const void*)fwd_kernel, 512, LDS_BYTES) != hipSuccess || per_cu < 1) { fprintf(stderr, "occupancy query: %d\n", per_cu); per_cu = 1; }
        (void)hipGetLastError();
        grid = cus > 0 ? cus : 256;
        if (ws_size < WS_END) fprintf(stderr, "workspace too small: %zu < %zu\n", ws_size, (size_t)WS_END);
    }
    (void)hipMemsetAsync((char*)d_ws + WS_BAR, 0, 16384, stream);
    Params p{};
    for (int i = 0; i < 27; ++i) p.in[i] = (const float*)d_in[i];
    p.out = (float*)d_out; p.wsp = (unsigned char*)d_ws;
    void* args[] = {&p};
    hipError_t e = hipLaunchCooperativeKernel((const void*)fwd_kernel, dim3(grid), dim3(512), args, LDS_BYTES, stream);
    if (e != hipSuccess) fprintf(stderr, "cooperative launch failed: %s (grid %d)\n", hipGetErrorString(e), grid);
}
```

```cpp
#include <hip/hip_runtime.h>
#include <hip/hip_cooperative_groups.h>
#include <cstdio>
#include <cstdint>
namespace cg = cooperative_groups;

#define LAS __attribute__((address_space(3)))
typedef unsigned short bf16_t;
typedef short bf16x8 __attribute__((ext_vector_type(8)));
typedef float f32x4 __attribute__((ext_vector_type(4)));
typedef float f32x2 __attribute__((ext_vector_type(2)));
typedef unsigned u32x4 __attribute__((ext_vector_type(4)));
typedef unsigned u32x2 __attribute__((ext_vector_type(2)));
typedef int v8i __attribute__((ext_vector_type(8)));

#ifndef DBG_STOP
#define DBG_STOP 0
#endif
#ifndef PROBE_MASK
#define PROBE_MASK 0
#endif
#ifndef REP_P0
#define REP_P0 1
#endif
#ifndef REP_P1
#define REP_P1 1
#endif
#ifndef REP_X
#define REP_X 1
#endif
#ifndef REP_P6
#define REP_P6 1
#endif
#ifndef REP_P7
#define REP_P7 1
#endif
#ifndef REP_P345
#define REP_P345 1
#endif
constexpr int NT = 12288, NTP = 4096, DM = 1024, NCH = 768, DFF = 2816;
constexpr float EPS = 1e-6f;

constexpr size_t AL(size_t x) { return (x + 255) & ~(size_t)255; }
constexpr size_t WS_CTL = 0;
constexpr size_t WS_MOD = 4096;
constexpr size_t WS_SVGU = WS_MOD + AL(3 * 6144 * 4);
constexpr size_t WS_MODP = AL(WS_SVGU + 3 * 5632 * 4);
constexpr size_t WS_SSQ2 = AL(WS_MODP + 32 * 3 * 6144 * 4);
constexpr size_t WS_SSQ3 = AL(WS_SSQ2 + (size_t)NT * 16 * 4);
constexpr size_t WS_W1T = AL(WS_SSQ3 + (size_t)NT * 16 * 4);
constexpr size_t WS_WFT = WS_W1T + 2560 * 1024 * 2;
constexpr size_t WS_WGLU = WS_WFT + 1024 * 1024 * 2;
constexpr size_t WS_WPS = WS_WGLU + 512 * 512 * 2;
constexpr size_t WS_WPF = WS_WPS + 1024 * 512 * 2;
constexpr size_t WS_WO = WS_WPF + 1024 * 512 * 2;
constexpr size_t WS_WGU = WS_WO + 1024 * 1024 * 2;
constexpr size_t WS_WD = WS_WGU + (size_t)5632 * 1024 * 2;
constexpr size_t WS_R1 = AL(WS_WD + (size_t)1024 * 2816 * 2);
constexpr size_t WS_R3 = WS_R1 + (size_t)NT * 2048 * 2;
constexpr size_t WS_R4 = WS_R3 + (size_t)NT * 1024 * 2;
constexpr size_t WS_XP = WS_R4 + (size_t)16777216;
constexpr size_t WS_R5 = WS_R4 + (size_t)NT * 1024 * 2;
constexpr size_t WS_YS = WS_R5 + (size_t)NT * 512 * 2;
constexpr size_t WS_YF = WS_YS + (size_t)NT * 512 * 2;
constexpr size_t WS_R2 = WS_YF + (size_t)NT * 512 * 2;
constexpr size_t WS_SF = WS_R2 + (size_t)NT * 1024 * 2;
constexpr size_t WS_ME = WS_SF + (size_t)32 * 256 * 256 * 2;
constexpr size_t WS_KK = WS_ME + (size_t)32 * 256 * 512 * 2;
constexpr size_t WS_A16 = WS_KK + (size_t)32 * 2 * 4096 * 4;
constexpr size_t WS_D1 = WS_A16 + 32 * 2 * 64 * 8;
constexpr size_t WS_D2 = WS_D1 + 256 * 256 * 2;
constexpr size_t WS_DP = WS_D2 + 256 * 512 * 2;
constexpr size_t WS_TW = WS_DP + 256 * 512 * 2;
constexpr size_t WS_BAR = WS_TW + 64 * 64 * 8;
constexpr size_t WS_CNT = WS_BAR + 16384;
constexpr size_t WS_END = WS_CNT + 16384;

__device__ __forceinline__ unsigned cvt_pk_bf16(float lo, float hi) { unsigned r; asm volatile("v_cvt_pk_bf16_f32 %0, %1, %2" : "=v"(r) : "v"(lo), "v"(hi)); return r; }
__device__ __forceinline__ float bf2f(unsigned short b) { return __uint_as_float(((unsigned)b) << 16); }
__device__ __forceinline__ float bflo(unsigned w) { return __uint_as_float(w << 16); }
__device__ __forceinline__ float bfhi(unsigned w) { return __uint_as_float(w & 0xffff0000u); }
__device__ __forceinline__ float sigm(float x) { return __builtin_amdgcn_rcpf(1.0f + __expf(-x)); }
__device__ __forceinline__ float gelu_tanh(float x) { const float u = 0.7978845608028654f * (x + 0.044715f * x * x * x); return x * sigm(2.0f * u); }
__device__ __forceinline__ float wave_sum(float v) {
#pragma unroll
    for (int o = 1; o < 64; o <<= 1) v += __shfl_xor(v, o);
    return v;
}
__device__ __forceinline__ void st16(void* p, u32x4 v) { asm volatile("global_store_dwordx4 %0, %1, off sc1\n\ts_nop 1" :: "v"(p), "v"(v) : "memory"); }
__device__ __forceinline__ void st16f(void* p, f32x4 v) { asm volatile("global_store_dwordx4 %0, %1, off sc1\n\ts_nop 1" :: "v"(p), "v"(v) : "memory"); }
__device__ __forceinline__ void st8(void* p, u32x2 v) { asm volatile("global_store_dwordx2 %0, %1, off sc1\n\ts_nop 1" :: "v"(p), "v"(v) : "memory"); }
__device__ __forceinline__ u32x2 pack8_fp8(f32x4 a, f32x4 b) { u32x2 w; int t = __builtin_amdgcn_cvt_pk_fp8_f32(a[0], a[1], 0, false); t = __builtin_amdgcn_cvt_pk_fp8_f32(a[2], a[3], t, true); w.x = (unsigned)t;
    t = __builtin_amdgcn_cvt_pk_fp8_f32(b[0], b[1], 0, false); t = __builtin_amdgcn_cvt_pk_fp8_f32(b[2], b[3], t, true); w.y = (unsigned)t; return w; }
__device__ __forceinline__ void st4f(float* p, float v) { asm volatile("global_store_dword %0, %1, off sc1\n\ts_nop 1" :: "v"(p), "v"(v) : "memory"); }
__device__ __forceinline__ void st2(bf16_t* p, unsigned v) { asm volatile("global_store_short %0, %1, off sc1\n\ts_nop 1" :: "v"(p), "v"(v) : "memory"); }
__device__ __forceinline__ u32x4 pack8(f32x4 a, f32x4 b) { u32x4 w; w.x = cvt_pk_bf16(a[0], a[1]); w.y = cvt_pk_bf16(a[2], a[3]); w.z = cvt_pk_bf16(b[0], b[1]); w.w = cvt_pk_bf16(b[2], b[3]); return w; }
__device__ __forceinline__ void unpack8(u32x4 w, f32x4& a, f32x4& b) { a = (f32x4){bflo(w.x), bfhi(w.x), bflo(w.y), bfhi(w.y)}; b = (f32x4){bflo(w.z), bfhi(w.z), bflo(w.w), bfhi(w.w)}; }
__device__ __forceinline__ void sincos_d(double th, double& s, double& c) {
    const double k = rint(th * 0.63661977236758134308);
    const double r = fma(-k, 6.123233995736766e-17, fma(-k, 1.5707963267948966, th));
    const double x2 = r * r;
    double sp = -7.6471637318198165e-13; sp = sp * x2 + 1.6059043836821613e-10; sp = sp * x2 - 2.5052108385441719e-08; sp = sp * x2 + 2.7557319223985891e-06;
    sp = sp * x2 - 1.9841269841269841e-04; sp = sp * x2 + 8.3333333333333333e-03; sp = sp * x2 - 1.6666666666666667e-01; sp = r + r * x2 * sp;
    double cp = 4.7794773323873853e-14; cp = cp * x2 - 1.1470745597729725e-11; cp = cp * x2 + 2.0876756987868099e-09; cp = cp * x2 - 2.7557319223985891e-07;
    cp = cp * x2 + 2.4801587301587302e-05; cp = cp * x2 - 1.3888888888888889e-03; cp = cp * x2 + 4.1666666666666667e-02; cp = cp * x2 - 0.5; cp = 1.0 + x2 * cp;
    const int q = ((int)k) & 3;
    s = (q == 0) ? sp : (q == 1) ? cp : (q == 2) ? -sp : -cp;
    c = (q == 0) ? cp : (q == 1) ? -sp : (q == 2) ? -cp : sp;
}
__device__ __forceinline__ void sincos_frac(int j, int N, float& s, float& c) { double ds, dc; sincos_d(6.283185307179586476925 * (double)(j & (N - 1)) / (double)N, ds, dc); s = (float)ds; c = (float)dc; }

#define XB_TMO      128
#define XB_XCNT(j)  (256  + 64 * (j))
#define XB_XSUB(j)  (1280 + 64 * (j))
#define XB_XGEN(j)  (2304 + 64 * (j))
#define XB_TOP      3328
#define XB_TOPGEN   3392
#define XCD_BAR_WORDS 3456
#define XB_SPIN_CAP (1u << 18)
__device__ __forceinline__ unsigned xb_ld(unsigned* p)              { return __hip_atomic_load(p, __ATOMIC_RELAXED, __HIP_MEMORY_SCOPE_AGENT); }
__device__ __forceinline__ unsigned xb_add(unsigned* p, unsigned v) { return __hip_atomic_fetch_add(p, v, __ATOMIC_RELAXED, __HIP_MEMORY_SCOPE_AGENT); }
__device__ __forceinline__ unsigned xb_xcc_id() { return (unsigned)__builtin_amdgcn_s_getreg((3 << 11) | 20) & 0xFu; }
#define XB_SPIN(cond, bar) do { unsigned _sp = 0; while (cond) { __builtin_amdgcn_s_sleep(6); \
    if ((++_sp & 255u) == 0u) { if (xb_ld(&(bar)[XB_TMO])) break; if (_sp > XB_SPIN_CAP) { atomicAdd(&(bar)[XB_TMO], 1u); break; } } } } while (0)
struct XcdBarrier { unsigned* bar; unsigned x; volatile LAS unsigned* st; };
__device__ __forceinline__ XcdBarrier xcd_barrier_post(unsigned* bar, volatile LAS unsigned* st) {
    XcdBarrier b; b.bar = bar; b.x = xb_xcc_id(); b.st = st;
    if (threadIdx.x == 0) (void)xb_add(&bar[XB_XCNT(b.x)], 1u);
    return b;
}
__device__ __forceinline__ void xcd_barrier_complete(unsigned* bar, unsigned x, unsigned& nloc, unsigned& nx) {
    const unsigned G = gridDim.x * gridDim.y * gridDim.z;
    unsigned sum, cnt, mine, sp = 0u;
    for (;;) {
        sum = 0u; cnt = 0u; mine = 0u;
#pragma unroll
        for (unsigned j = 0; j < 16; ++j) { const unsigned c = xb_ld(&bar[XB_XCNT(j)]); sum += c; cnt += (c > 0u) ? 1u : 0u; mine = (j == x) ? c : mine; }
        if (sum == G) break;
        __builtin_amdgcn_s_sleep(1);
        if ((++sp & 255u) == 0u) { if (xb_ld(&bar[XB_TMO])) break; if (sp > XB_SPIN_CAP) { atomicAdd(&bar[XB_TMO], 1u); break; } }
    }
    nloc = mine > 0u ? mine : 1u; nx = cnt > 0u ? cnt : 1u;
}
__device__ __forceinline__ void xcd_barrier(const XcdBarrier& b) {
    asm volatile("s_waitcnt vmcnt(0)" ::: "memory");
    __syncthreads();
    if (threadIdx.x == 0) {
        unsigned* bar = b.bar;
        __builtin_amdgcn_s_waitcnt(0);
        unsigned nloc = b.st[0], nx = b.st[1];
        if (nloc == 0u) { xcd_barrier_complete(bar, b.x, nloc, nx); b.st[0] = nloc; b.st[1] = nx; }
        const unsigned old = xb_add(&bar[XB_XSUB(b.x)], 1u);
        const unsigned gen = old / nloc;
        if (old + 1u == (gen + 1u) * nloc) {
            const unsigned og = xb_add(&bar[XB_TOP], 1u);
            const unsigned tg = og / nx;
            if (og + 1u == (tg + 1u) * nx) xb_add(&bar[XB_TOPGEN], 1u);
            else XB_SPIN(xb_ld(&bar[XB_TOPGEN]) == tg, bar);
            xb_add(&bar[XB_XGEN(b.x)], 1u);
            __builtin_amdgcn_fence(__ATOMIC_ACQUIRE, "agent");
            asm volatile("s_waitcnt vmcnt(0)" ::: "memory");
        } else {
            XB_SPIN(xb_ld(&bar[XB_XGEN(b.x)]) == gen, bar);
            __builtin_amdgcn_fence(__ATOMIC_ACQUIRE, "agent");
            asm volatile("s_waitcnt vmcnt(0)" ::: "memory");
        }
    }
    __syncthreads();
}

constexpr int HTB = 128 * 64 * 2;
__device__ __forceinline__ int lds_byte(int r, int c) { const int st = (r >> 4) * 2 + (c >> 5), rr = r & 15, cc = c & 31, ob = rr * 64 + cc * 2; return st * 1024 + (ob ^ (((ob >> 9) & 1) << 5)); }
__device__ __forceinline__ void stage_rc(int b, int& R, int& C) { const int st = b / 1024, sb = b % 1024, swz = sb ^ (((sb >> 9) & 1) << 5); R = (st >> 1) * 16 + swz / 64; C = (st & 1) * 32 + (swz % 64) / 2; }
__device__ __forceinline__ int perm32(int rho) { const int n = rho >> 4, i = rho & 15; return 8 * (i >> 2) + 4 * n + (i & 3); }
struct Unit { const char* A; const char* B; int pm, pn, sub; };
__device__ __forceinline__ void tile_of(int j, int nM, int nN, int& pm, int& pn) {
    const int nwg = nM * nN; int wgid = j;
    { const int q = nwg / 8, r = nwg % 8, xcd = wgid % 8, off = wgid / 8; wgid = (xcd < r ? xcd * (q + 1) : r * (q + 1) + (xcd - r) * q) + off; }
    const int nig = 8 * nN, gid = wgid / nig, fm = gid * 8, gsz = (nM - fm) < 8 ? (nM - fm) : 8;
    pm = fm + ((wgid % nig) % gsz); pn = (wgid % nig) / gsz;
}
template <class G>
__device__ __forceinline__ void unit_ready(const G& g, const Unit& u, int wid) {
    if constexpr (G::WAITS) {
        if (wid == 0) { unsigned need; const unsigned* c = g.wait_ctr(u, need); unsigned spins = 0;
            while ((unsigned)__builtin_amdgcn_readfirstlane(__hip_atomic_load(c, __ATOMIC_RELAXED, __HIP_MEMORY_SCOPE_AGENT)) < need) { __builtin_amdgcn_s_sleep(20); if (++spins > (1u << 20)) break; }
            if constexpr (G::WAIT2X) { unsigned need2; const unsigned* c2 = g.wait_ctr2(u, need2); spins = 0;
                while ((unsigned)__builtin_amdgcn_readfirstlane(__hip_atomic_load(c2, __ATOMIC_RELAXED, __HIP_MEMORY_SCOPE_AGENT)) < need2) { __builtin_amdgcn_s_sleep(2); if (++spins > (1u << 22)) break; } }
            __builtin_amdgcn_fence(__ATOMIC_ACQUIRE, "agent"); asm volatile("s_waitcnt vmcnt(0)" ::: "memory"); }
        asm volatile("" ::: "memory"); __builtin_amdgcn_s_barrier(); asm volatile("" ::: "memory");
    }
}
template <class G>
__device__ __forceinline__ void unit_done(const G& g, const Unit& u, int lane) {
    if constexpr (G::SIGNALS) { asm volatile("s_waitcnt vmcnt(0)" ::: "memory"); if (lane == 0) __hip_atomic_fetch_add(g.done_ctr(u), 1u, __ATOMIC_RELAXED, __HIP_MEMORY_SCOPE_AGENT); }
}
template <class G>
__device__ __forceinline__ void gemm_phase(LAS unsigned char* lds, const G& g, const int L0, const int count) {
    constexpr int K = G::K, nt = K / 64;
    static_assert(nt % 2 == 0 && nt >= 2, "K");
    int tid = threadIdx.x; asm volatile("" : "+v"(tid));
    const int wid = __builtin_amdgcn_readfirstlane(tid >> 6), lane = tid & 63, wr = wid >> 2, wc = wid & 3, fr = lane & 15, fq = lane >> 4;
    const int Gn = gridDim.x;
    int j = ((int)blockIdx.x - L0) % Gn; if (j < 0) j += Gn;
    if (j >= count) return;
    unsigned voffA[2], voffB[2];
#pragma unroll
    for (int i = 0; i < 2; ++i) { int R, C; stage_rc(tid * 16 + i * 8192, R, C); const int Rb = G::PERM ? (R & ~31) + perm32(R & 31) : R;
        voffA[i] = g.offA(R) + (unsigned)C * 2u; voffB[i] = g.offB(Rb) + (unsigned)C * 2u; }
    const size_t kstep = 128, hsA = G::HSA, hsB = G::HSB;
    const unsigned ldsw = (unsigned)wid * 1024u;
    const int aoff = lds_byte(wr * (16 * G::MH) + fr, fq * 8), boff = lds_byte(wc * 32 + fr, fq * 8);
#define PG8_SA(b, h) (((b) * 2 + (h)) * HTB)
#define PG8_SB(b, h) ((4 + (b) * 2 + (h)) * HTB)
#define PG8_STAGE(bufoff, gbase, voff) do { _Pragma("unroll") for (int _i = 0; _i < 2; ++_i) \
        __builtin_amdgcn_global_load_lds((const unsigned*)((const char*)(gbase) + (voff)[_i]), (LAS unsigned*)(lds + (bufoff) + ldsw + _i * 8192), 16, 0, 0); } while (0)
#define PG8_CAT(x, y) __builtin_bit_cast(v8i, __builtin_shufflevector(x, y, 0, 1, 2, 3, 4, 5, 6, 7, 8, 9, 10, 11, 12, 13, 14, 15))
#define PG8_LDA(dst, b, h) do { _Pragma("unroll") for (int m = 0; m < G::MH; ++m) { \
        if constexpr (G::FP8) dst##8[m] = PG8_CAT(*(const LAS bf16x8*)(lds + PG8_SA(b, h) + aoff + m * 2048), *(const LAS bf16x8*)(lds + PG8_SA(b, h) + aoff + m * 2048 + 1024)); \
        else { _Pragma("unroll") for (int k = 0; k < 2; ++k) dst[m][k] = *(const LAS bf16x8*)(lds + PG8_SA(b, h) + aoff + m * 2048 + k * 1024); } } } while (0)
#define PG8_LDB(dst, b, h) do { _Pragma("unroll") for (int n = 0; n < 2; ++n) { \
        if constexpr (G::FP8) dst##8[n] = PG8_CAT(*(const LAS bf16x8*)(lds + PG8_SB(b, h) + boff + n * 2048), *(const LAS bf16x8*)(lds + PG8_SB(b, h) + boff + n * 2048 + 1024)); \
        else { _Pragma("unroll") for (int k = 0; k < 2; ++k) dst[n][k] = *(const LAS bf16x8*)(lds + PG8_SB(b, h) + boff + n * 2048 + k * 1024); } } } while (0)
#define PG8_MMA(ai, bj, At, Bt) do { __builtin_amdgcn_s_setprio(1); _Pragma("unroll") for (int m = 0; m < G::MH; ++m) _Pragma("unroll") for (int n = 0; n < 2; ++n) { \
        if constexpr (G::FP8) asm volatile("v_mfma_f32_16x16x128_f8f6f4 %0, %1, %2, %0" : "+v"(acc[ai][bj][m][n]) : "v"(Bt##8[n]), "v"(At##8[m])); \
        else { _Pragma("unroll") for (int k = 0; k < 2; ++k) acc[ai][bj][m][n] = __builtin_amdgcn_mfma_f32_16x16x32_bf16(Bt[n][k], At[m][k], acc[ai][bj][m][n], 0, 0, 0); } } \
        __builtin_amdgcn_s_setprio(0); } while (0)
#ifdef SAFE_ENGINE
#define PG8_WAIT_V(n) asm volatile("s_waitcnt vmcnt(0)" ::: "memory")
#else
#define PG8_WAIT_V(n) asm volatile("s_waitcnt vmcnt(" #n ")" ::: "memory")
#endif
#define PG8_WAIT_L(n) asm volatile("s_waitcnt lgkmcnt(" #n ")" ::: "memory")
#define PG8_BAR __builtin_amdgcn_s_barrier()
#define PG8_SCHED __builtin_amdgcn_sched_barrier(0)
    Unit cur, nxt;
    int sub = 0;
    if constexpr (G::SUBS == 1) { g.unit(j, cur); cur.sub = 0; } else g.unit(j, 0, cur);
    asm volatile("" : "+s"(cur.A), "+s"(cur.B));
    f32x4 acc[2][2][4][2];
#pragma unroll
    for (int a = 0; a < 2; ++a)
#pragma unroll
        for (int b = 0; b < 2; ++b)
#pragma unroll
            for (int m = 0; m < 4; ++m)
#pragma unroll
                for (int n = 0; n < 2; ++n) acc[a][b][m][n] = (f32x4){0.f, 0.f, 0.f, 0.f};
    bf16x8 At[4][2], B0[2][2], B1[2][2];
    v8i At8[4], B08[2], B18[2];
    const char* cA = cur.A; const char* cB = cur.B;
    unit_ready(g, cur, wid);
    PG8_STAGE(PG8_SB(0, 0), cB, voffB); PG8_STAGE(PG8_SB(0, 1), cB + hsB, voffB); PG8_STAGE(PG8_SA(0, 0), cA, voffA); PG8_STAGE(PG8_SA(0, 1), cA + hsA, voffA);
    if (wr == 1) PG8_BAR;
    PG8_WAIT_V(2); PG8_BAR;
    PG8_STAGE(PG8_SB(1, 0), cB + kstep, voffB); PG8_STAGE(PG8_SA(1, 0), cA + kstep, voffA); PG8_STAGE(PG8_SB(1, 1), cB + hsB + kstep, voffB);
    PG8_WAIT_V(6); PG8_BAR;
    for (;;) {
        const bool more_subs = (G::SUBS > 1) && (sub + 1 < G::SUBS);
        const bool has_next = more_subs || (j + Gn < count);
        if (has_next) { if constexpr (G::SUBS == 1) { g.unit(j + Gn, nxt); nxt.sub = 0; } else { if (more_subs) g.unit(j, sub + 1, nxt); else g.unit(j + Gn, 0, nxt); }
            asm volatile("" : "+s"(nxt.A), "+s"(nxt.B)); }
        const char* nA = has_next ? nxt.A : cA; const char* nB = has_next ? nxt.B : cB;
#pragma unroll 1
        for (int t = 0; t < nt; t += 2) {
            const bool last = (t == nt - 2);
            const char* a1 = cA + (size_t)(t + 1) * kstep;
            const char* a2 = last ? nA : cA + (size_t)(t + 2) * kstep; const char* b2 = last ? nB : cB + (size_t)(t + 2) * kstep;
            const char* a3 = a2 + kstep; const char* b3 = b2 + kstep;
            if (last && has_next) unit_ready(g, nxt, wid);
            PG8_LDB(B0, 0, 0); PG8_LDB(B1, 0, 1); PG8_SCHED; PG8_LDA(At, 0, 0); PG8_STAGE(PG8_SA(1, 1), a1 + hsA, voffA);
            PG8_WAIT_V(8); PG8_WAIT_L(0); PG8_BAR; PG8_MMA(0, 0, At, B0); PG8_MMA(0, 1, At, B1); PG8_BAR; PG8_SCHED;
            PG8_LDA(At, 0, 1); PG8_STAGE(PG8_SB(0, 0), b2, voffB); PG8_STAGE(PG8_SB(0, 1), b2 + hsB, voffB); PG8_STAGE(PG8_SA(0, 0), a2, voffA);
            PG8_WAIT_V(8); PG8_WAIT_L(0); PG8_BAR; PG8_MMA(1, 0, At, B0); PG8_MMA(1, 1, At, B1); PG8_BAR; PG8_SCHED;
            PG8_LDB(B0, 1, 0); PG8_LDB(B1, 1, 1); PG8_SCHED; PG8_LDA(At, 1, 0); PG8_STAGE(PG8_SA(0, 1), a2 + hsA, voffA);
            PG8_WAIT_V(8); PG8_WAIT_L(0); PG8_BAR; PG8_MMA(0, 0, At, B0); PG8_MMA(0, 1, At, B1); PG8_BAR; PG8_SCHED;
            PG8_LDA(At, 1, 1); PG8_STAGE(PG8_SB(1, 0), b3, voffB); PG8_STAGE(PG8_SB(1, 1), b3 + hsB, voffB); PG8_STAGE(PG8_SA(1, 0), a3, voffA);
            PG8_WAIT_V(8); PG8_WAIT_L(0); PG8_BAR; PG8_MMA(1, 0, At, B0); PG8_MMA(1, 1, At, B1); PG8_BAR; PG8_SCHED;
        }
        if (wr == 0) PG8_BAR;
        if constexpr (G::FP8) asm volatile("s_nop 15\n\ts_nop 15" ::: "memory");
        g.epi(acc, cur, wr, wc, fr, fq);
        if (!more_subs) unit_done(g, cur, lane);
        if (!has_next) break;
        if (!more_subs) {
#pragma unroll
        for (int a = 0; a < 2; ++a)
#pragma unroll
            for (int b = 0; b < 2; ++b)
#pragma unroll
                for (int m = 0; m < 4; ++m)
#pragma unroll
                    for (int n = 0; n < 2; ++n) acc[a][b][m][n] = (f32x4){0.f, 0.f, 0.f, 0.f};
        }
        cur = nxt; cA = nA; cB = nB; if (more_subs) ++sub; else { sub = 0; j += Gn; }
        if (wr == 1) PG8_BAR;
    }
    PG8_WAIT_V(0);
    PG8_BAR;
#undef PG8_SA
#undef PG8_SB
#undef PG8_STAGE
#undef PG8_LDA
#undef PG8_LDB
#undef PG8_MMA
#undef PG8_CAT
#undef PG8_WAIT_V
#undef PG8_WAIT_L
#undef PG8_BAR
#undef PG8_SCHED
}

__device__ __forceinline__ int mod_of(size_t t) { return t < 4096 ? 0 : (t < 8192 ? 1 : 2); }
#define EPI_ARGS f32x4 (&acc)[2][2][4][2], const Unit& u, int wr, int wc, int fr, int fq
struct G1a {
    static constexpr bool PERM = true, WAITS = false, SIGNALS = false; static constexpr bool FP8 = false; static constexpr bool WAIT2X = false; static constexpr int MH = 4, SUBS = 1, K = 1024; static constexpr size_t HSA = 128 * 2048, HSB = 128 * 2048;
    const char* HB; const char* W; bf16_t* UH; bf16_t* SG;
    __device__ __forceinline__ unsigned offA(int R) const { return (unsigned)R * 2048u; }
    __device__ __forceinline__ unsigned offB(int R) const { return (unsigned)R * 2048u; }
    __device__ __forceinline__ void unit(int j, Unit& u) const { tile_of(j, 48, 10, u.pm, u.pn); u.A = HB + (size_t)u.pm * 256 * 2048; u.B = W + (size_t)u.pn * 256 * 2048; }
    __device__ __forceinline__ void epi(EPI_ARGS) const {
#pragma unroll
        for (int ai = 0; ai < 2; ++ai)
#pragma unroll
            for (int m = 0; m < 4; ++m) { const int t = u.pm * 256 + 128 * ai + 64 * wr + 16 * m + fr;
#pragma unroll
                for (int bj = 0; bj < 2; ++bj) { const int col = u.pn * 256 + 128 * bj + 32 * wc + 8 * fq; const f32x4 a = acc[ai][bj][m][0], b = acc[ai][bj][m][1];
                    if (u.pn < 2) { const int gg = col >> 4, h0 = col & 15; st16(UH + ((size_t)(gg * NCH + (t >> 4)) * 512 + (t & 15) * 16 + h0), pack8(a, b)); }
                    else { f32x4 sa, sb;
#pragma unroll
                        for (int q = 0; q < 4; ++q) { sa[q] = sigm(a[q]); sb[q] = sigm(b[q]); }
                        st16(SG + ((size_t)t * 2048 + (col - 512)), pack8(sa, sb)); } } }
    }
};
struct G1b {
    static constexpr bool PERM = true, WAITS = false, SIGNALS = false; static constexpr bool FP8 = false; static constexpr bool WAIT2X = false; static constexpr int MH = 4, SUBS = 1, K = 1024; static constexpr size_t HSA = 128 * 2048, HSB = 2 * 2048;
    const char* HB; const char* W; bf16_t* XS;
    __device__ __forceinline__ unsigned offA(int R) const { return (unsigned)R * 2048u; }
    __device__ __forceinline__ unsigned offB(int R) const { return (unsigned)(64 * (R & 63) + (R >> 6)) * 2048u; }
    __device__ __forceinline__ void unit(int j, Unit& u) const { tile_of(j, 4, 32, u.pm, u.pn); u.A = W + (size_t)u.pm * 256 * 2048; const int s = u.pn >> 4, a0 = 4 * (u.pn & 15); u.B = HB + (size_t)(NTP + 4096 * s + a0) * 2048; }
    __device__ __forceinline__ void epi(EPI_ARGS) const {
        const int s = u.pn >> 4, a0 = 4 * (u.pn & 15);
#pragma unroll
        for (int ai = 0; ai < 2; ++ai)
#pragma unroll
            for (int m = 0; m < 4; ++m) { const int q = 64 * wr + 16 * m + fr, gq = u.pm * 128 + q;
#pragma unroll
                for (int bj = 0; bj < 2; ++bj) { const int la = a0 + 2 * bj + (wc >> 1), lb0 = 32 * (wc & 1) + 8 * fq;
                    const size_t idx = ((((size_t)((gq >> 1) * 2 + s) * 64 + la) * 2 + (gq & 1)) * 2 + ai) * 64 + lb0;
                    st16(XS + idx, pack8(acc[ai][bj][m][0], acc[ai][bj][m][1])); } }
    }
};
struct G1c {
    static constexpr bool PERM = true, WAITS = false, SIGNALS = false; static constexpr bool FP8 = false; static constexpr bool WAIT2X = false; static constexpr int MH = 4, SUBS = 1, K = 1024; static constexpr size_t HSA = 128 * 2048, HSB = 128 * 2048;
    const char* HB; const char* W; bf16_t* XP;
    __device__ __forceinline__ unsigned offA(int R) const { return (unsigned)R * 2048u; }
    __device__ __forceinline__ unsigned offB(int R) const { return (unsigned)R * 2048u; }
    __device__ __forceinline__ void unit(int j, Unit& u) const { tile_of(j, 4, 16, u.pm, u.pn); u.A = W + (size_t)u.pm * 256 * 2048; u.B = HB + (size_t)(256 * u.pn) * 2048; }
    __device__ __forceinline__ void epi(EPI_ARGS) const {
#pragma unroll
        for (int ai = 0; ai < 2; ++ai)
#pragma unroll
            for (int m = 0; m < 4; ++m) { const int q = 64 * wr + 16 * m + fr, gq = u.pm * 128 + q;
#pragma unroll
                for (int bj = 0; bj < 2; ++bj) { const int l0 = 128 * bj + 32 * wc + 8 * fq;
                    const size_t idx = ((size_t)(u.pn * 512 + gq) * 2 + ai) * 256 + l0;
                    st16(XP + idx, pack8(acc[ai][bj][m][0], acc[ai][bj][m][1])); } }
    }
};
struct Gglu {
    static constexpr bool PERM = true, WAITS = false, SIGNALS = true; static constexpr bool FP8 = false; static constexpr bool WAIT2X = false; static constexpr int MH = 3, SUBS = 1, K = 512; static constexpr size_t HSA = 96 * 1024, HSB = 128 * 1024;
    const char* ZB; const char* W; const float* bias; bf16_t* YS;
    unsigned* CNT;
    __device__ __forceinline__ unsigned* done_ctr(const Unit& u) const { return CNT + (0 * 48 + u.pm) * 16; }
    __device__ __forceinline__ unsigned offA(int R) const { return (unsigned)R * 1024u; }
    __device__ __forceinline__ unsigned offB(int R) const { return (unsigned)R * 1024u; }
    __device__ __forceinline__ void unit(int j, Unit& u) const { tile_of(j, 64, 2, u.pm, u.pn); u.A = ZB + (size_t)u.pm * 192 * 1024; u.B = W + (size_t)u.pn * 256 * 1024; }
    __device__ __forceinline__ void epi(EPI_ARGS) const {
#pragma unroll
        for (int bj = 0; bj < 2; ++bj) { const int col = u.pn * 256 + 128 * bj + 32 * wc + 8 * fq;
            const f32x4 b0 = *(const f32x4*)(bias + col), b1 = *(const f32x4*)(bias + col + 4);
#pragma unroll
            for (int ai = 0; ai < 2; ++ai)
#pragma unroll
                for (int m = 0; m < 3; ++m) { const int t = u.pm * 192 + 96 * ai + 48 * wr + 16 * m + fr;
                    f32x4 z0, z1; unpack8(*(const u32x4*)((const bf16_t*)ZB + (size_t)t * 512 + col), z0, z1);
                    f32x4 a = acc[ai][bj][m][0] + b0, b = acc[ai][bj][m][1] + b1;
#pragma unroll
                    for (int q = 0; q < 4; ++q) { a[q] = z0[q] * sigm(a[q]); b[q] = z1[q] * sigm(b[q]); }
                    st16(YS + (size_t)t * 512 + col, pack8(a, b)); asm volatile("" ::: "memory"); } }
    }
};
struct Gps {
    static constexpr bool PERM = true, WAITS = true, SIGNALS = false; static constexpr bool FP8 = false; static constexpr bool WAIT2X = false; static constexpr int MH = 4, SUBS = 1, K = 512; static constexpr size_t HSA = 128 * 1024, HSB = 128 * 1024;
    const char* A; const char* W; const bf16_t* SG; float* T1;
    unsigned* CNT;
    __device__ __forceinline__ const unsigned* wait_ctr(const Unit& u, unsigned& need) const { need = 2 * 8; return CNT + (0 * 48 + u.pm) * 16; }
    __device__ __forceinline__ unsigned offA(int R) const { return (unsigned)R * 1024u; }
    __device__ __forceinline__ unsigned offB(int R) const { return (unsigned)R * 1024u; }
    __device__ __forceinline__ void unit(int j, Unit& u) const { tile_of(j, 48, 4, u.pm, u.pn); u.A = A + (size_t)u.pm * 256 * 1024; u.B = W + (size_t)u.pn * 256 * 1024; }
    __device__ __forceinline__ void epi(EPI_ARGS) const {
#pragma unroll
        for (int ai = 0; ai < 2; ++ai)
#pragma unroll
            for (int m = 0; m < 4; ++m) { const int t = u.pm * 256 + 128 * ai + 64 * wr + 16 * m + fr;
#pragma unroll
                for (int bj = 0; bj < 2; ++bj) { const int col = u.pn * 256 + 128 * bj + 32 * wc + 8 * fq;
                    f32x4 s0, s1; unpack8(*(const u32x4*)(SG + (size_t)t * 2048 + col), s0, s1);
                    *(f32x4*)(T1 + (size_t)t * 1024 + col) = s0 * acc[ai][bj][m][0]; *(f32x4*)(T1 + (size_t)t * 1024 + col + 4) = s1 * acc[ai][bj][m][1];     } asm volatile("" ::: "memory"); }
    }
};
struct Gpf {
    static constexpr bool PERM = true, WAITS = false, SIGNALS = false; static constexpr bool FP8 = false; static constexpr bool WAIT2X = false; static constexpr int MH = 4, SUBS = 1, K = 512; static constexpr size_t HSA = 128 * 1024, HSB = 128 * 1024;
    const char* A; const char* W; const bf16_t* SG; const float* T1; bf16_t* MB;
    __device__ __forceinline__ unsigned offA(int R) const { return (unsigned)R * 1024u; }
    __device__ __forceinline__ unsigned offB(int R) const { return (unsigned)R * 1024u; }
    __device__ __forceinline__ void unit(int j, Unit& u) const { tile_of(j, 48, 4, u.pm, u.pn); u.A = A + (size_t)u.pm * 256 * 1024; u.B = W + (size_t)u.pn * 256 * 1024; }
    __device__ __forceinline__ void epi(EPI_ARGS) const {
#pragma unroll
        for (int ai = 0; ai < 2; ++ai)
#pragma unroll
            for (int m = 0; m < 4; ++m) { const int t = u.pm * 256 + 128 * ai + 64 * wr + 16 * m + fr;
#pragma unroll
                for (int bj = 0; bj < 2; ++bj) { const int col = u.pn * 256 + 128 * bj + 32 * wc + 8 * fq;
                    f32x4 s0, s1; unpack8(*(const u32x4*)(SG + (size_t)t * 2048 + 1024 + col), s0, s1);
                    const f32x4 t0 = *(const f32x4*)(T1 + (size_t)t * 1024 + col), t1 = *(const f32x4*)(T1 + (size_t)t * 1024 + col + 4);
                    st16(MB + (size_t)t * 1024 + col, pack8(t0 + s0 * acc[ai][bj][m][0], t1 + s1 * acc[ai][bj][m][1])); } asm volatile("" ::: "memory"); }
    }
};
struct Gproj {
    static constexpr bool PERM = true, WAITS = true, SIGNALS = false; static constexpr bool FP8 = false; static constexpr bool WAIT2X = false; static constexpr int MH = 3, SUBS = 2, K = 512; static constexpr size_t HSA = 96 * 1024, HSB = 128 * 1024;
    const char* YS; const char* YF; const char* WPS; const char* WPF; const bf16_t* SG; bf16_t* MB; unsigned* CNT;
    __device__ __forceinline__ const unsigned* wait_ctr(const Unit& u, unsigned& need) const { need = u.sub == 0 ? 2 * 8 : 0; return CNT + (0 * 48 + u.pm) * 16; }
    __device__ __forceinline__ unsigned offA(int R) const { return (unsigned)R * 1024u; }
    __device__ __forceinline__ unsigned offB(int R) const { return (unsigned)R * 1024u; }
    __device__ __forceinline__ void unit(int j, int sub, Unit& u) const { tile_of(j, 64, 4, u.pm, u.pn); u.sub = sub; u.A = (sub ? YF : YS) + (size_t)u.pm * 192 * 1024; u.B = (sub ? WPF : WPS) + (size_t)u.pn * 256 * 1024; }
    __device__ __forceinline__ void epi(EPI_ARGS) const {
#pragma unroll
        for (int ai = 0; ai < 2; ++ai)
#pragma unroll
            for (int m = 0; m < 3; ++m) { const int t = u.pm * 192 + 96 * ai + 48 * wr + 16 * m + fr;
#pragma unroll
                for (int bj = 0; bj < 2; ++bj) { const int col = u.pn * 256 + 128 * bj + 32 * wc + 8 * fq;
                    f32x4 f0, f1; unpack8(*(const u32x4*)(SG + (size_t)t * 2048 + 1024 + col), f0, f1);
                    if (u.sub == 0) { f32x4 s0, s1; unpack8(*(const u32x4*)(SG + (size_t)t * 2048 + col), s0, s1);
#pragma unroll
                        for (int q = 0; q < 4; ++q) { acc[ai][bj][m][0][q] *= s0[q] * __builtin_amdgcn_rcpf(f0[q]); acc[ai][bj][m][1][q] *= s1[q] * __builtin_amdgcn_rcpf(f1[q]); } }
                    else st16(MB + (size_t)t * 1024 + col, pack8(acc[ai][bj][m][0] * f0, acc[ai][bj][m][1] * f1)); }
                asm volatile("" ::: "memory"); }
    }
};

struct Gwo {
    static constexpr bool PERM = true, WAITS = false, SIGNALS = false; static constexpr bool FP8 = false; static constexpr bool WAIT2X = false; static constexpr int MH = 3, SUBS = 1, K = 1024; static constexpr size_t HSA = 96 * 2048, HSB = 128 * 2048;
    const char* A; const char* W; const float* xp; const float* xs; const float* MOD; const float* g2; bf16_t* X1; bf16_t* A2B; float* SSQ;
    __device__ __forceinline__ unsigned offA(int R) const { return (unsigned)R * 2048u; }
    __device__ __forceinline__ unsigned offB(int R) const { return (unsigned)R * 2048u; }
    __device__ __forceinline__ void unit(int j, Unit& u) const { tile_of(j, 64, 4, u.pm, u.pn); u.A = A + (size_t)u.pm * 192 * 2048; u.B = W + (size_t)u.pn * 256 * 2048; }
    __device__ __forceinline__ void epi(EPI_ARGS) const {
#pragma unroll
        for (int ai = 0; ai < 2; ++ai)
#pragma unroll
            for (int m = 0; m < 3; ++m) { const size_t t = (size_t)u.pm * 192 + 96 * ai + 48 * wr + 16 * m + fr;
                const float* md = MOD + mod_of(t) * 6144;
                const float* xin = t < 4096 ? xp + t * 1024 : xs + (t - 4096) * 1024;
                float ss = 0.f;
#pragma unroll
                for (int bj = 0; bj < 2; ++bj) { const int col = u.pn * 256 + 128 * bj + 32 * wc + 8 * fq;
                    const f32x4 ga = *(const f32x4*)(md + 2048 + col), gb = *(const f32x4*)(md + 2048 + col + 4);
                    const f32x4 sa = (*(const f32x4*)(md + 4096 + col) + 1.0f) * *(const f32x4*)(g2 + col), sb = (*(const f32x4*)(md + 4096 + col + 4) + 1.0f) * *(const f32x4*)(g2 + col + 4);
                    const f32x4 x0 = *(const f32x4*)(xin + col) + ga * acc[ai][bj][m][0], x1 = *(const f32x4*)(xin + col + 4) + gb * acc[ai][bj][m][1];
                    *(u32x4*)(X1 + t * 1024 + col) = pack8(x0, x1);
                    st16(A2B + t * 1024 + col, pack8(x0 * sa, x1 * sb));
                    ss += (x0[0] * x0[0] + x0[1] * x0[1]) + (x0[2] * x0[2] + x0[3] * x0[3]) + (x1[0] * x1[0] + x1[1] * x1[1]) + (x1[2] * x1[2] + x1[3] * x1[3]); }
                ss += __shfl_xor(ss, 16); ss += __shfl_xor(ss, 32);
                if (fq == 0) st4f(SSQ + t * 16 + u.pn * 4 + wc, ss);
                asm volatile("" ::: "memory"); }
    }
};

struct Ggu {
    static constexpr bool PERM = true, WAITS = false, SIGNALS = true; static constexpr bool FP8 = false; static constexpr bool WAIT2X = false; static constexpr int MH = 3, SUBS = 1, K = 1024; static constexpr size_t HSA = 96 * 2048, HSB = 128 * 2048;
    const char* A; const char* W; const float* SSQ; const float* SV; bf16_t* FF;
    unsigned* CNT;
    __device__ __forceinline__ unsigned* done_ctr(const Unit& u) const { return CNT + (64 + u.pm) * 16; }
    __device__ __forceinline__ unsigned offA(int R) const { return (unsigned)R * 2048u; }
    __device__ __forceinline__ unsigned offB(int R) const { return (unsigned)R * 2048u; }
    __device__ __forceinline__ void unit(int j, Unit& u) const { tile_of(j, 64, 22, u.pm, u.pn); u.A = A + (size_t)u.pm * 192 * 2048; u.B = W + (size_t)u.pn * 256 * 2048; }
    __device__ __forceinline__ void epi(EPI_ARGS) const {
        const int col = u.pn * 128 + 32 * wc + 8 * fq;
#pragma unroll
        for (int ai = 0; ai < 2; ++ai)
#pragma unroll
            for (int m = 0; m < 3; ++m) { const size_t t = (size_t)u.pm * 192 + 96 * ai + 48 * wr + 16 * m + fr;
                const float* sv = SV + mod_of(t) * 5632 + u.pn * 256 + 32 * wc + 8 * fq;
                const f32x4 g0 = *(const f32x4*)(sv), g1 = *(const f32x4*)(sv + 4), u0 = *(const f32x4*)(sv + 128), u1 = *(const f32x4*)(sv + 132);
                const f32x4* sp = (const f32x4*)(SSQ + t * 16); const f32x4 q4 = (sp[0] + sp[1]) + (sp[2] + sp[3]);
                const float r = __builtin_amdgcn_rsqf(((q4[0] + q4[1]) + (q4[2] + q4[3])) * (1.0f / 1024.0f) + EPS);
                f32x4 ga = acc[ai][0][m][0] * r + g0, gb = acc[ai][0][m][1] * r + g1; const f32x4 ua = acc[ai][1][m][0] * r + u0, ub = acc[ai][1][m][1] * r + u1;
#pragma unroll
                for (int q = 0; q < 4; ++q) { ga[q] = ga[q] * sigm(ga[q]) * ua[q]; gb[q] = gb[q] * sigm(gb[q]) * ub[q]; }
                st8((unsigned char*)FF + t * DFF + col, pack8_fp8(ga, gb));     asm volatile("" ::: "memory"); }
    }
};

struct Gdn {
    static constexpr bool PERM = true, WAITS = true, SIGNALS = false; static constexpr bool FP8 = true; static constexpr bool WAIT2X = false; static constexpr int MH = 3, SUBS = 1, K = 1408  ; static constexpr size_t HSA = 96 * 2816, HSB = 128 * 2816;
    const char* A; const char* W; const bf16_t* X1; const float* MOD; float* OUT; float* SSQ; const float* fing;
    unsigned* CNT;
    __device__ __forceinline__ const unsigned* wait_ctr(const Unit& u, unsigned& need) const { need = 22 * 8; return CNT + (64 + u.pm) * 16; }
    __device__ __forceinline__ unsigned offA(int R) const { return (unsigned)R * 2816u; }
    __device__ __forceinline__ unsigned offB(int R) const { return (unsigned)R * 2816u; }
    __device__ __forceinline__ void unit(int j, Unit& u) const { tile_of(j, 64, 4, u.pm, u.pn); u.A = A + (size_t)u.pm * 192 * 2816; u.B = W + (size_t)u.pn * 256 * 2816; }
    __device__ __forceinline__ void epi(EPI_ARGS) const {
        int pm_ = u.pm, pn_ = u.pn, fr_ = fr; asm volatile("" : "+s"(pm_), "+s"(pn_), "+v"(fr_));
#pragma unroll
        for (int ai = 0; ai < 2; ++ai)
#pragma unroll
            for (int m = 0; m < 3; ++m) { const size_t t = (size_t)pm_ * 192 + 96 * ai + 48 * wr + 16 * m + fr_;
                const float* md = MOD + mod_of(t) * 6144 + 5 * 1024;
                float ss = 0.f;
#pragma unroll
                for (int bj = 0; bj < 2; ++bj) { const int col = pn_ * 256 + 128 * bj + 32 * wc + 8 * fq;
                    const f32x4 ga = *(const f32x4*)(md + col) * 0.03125f, gb = *(const f32x4*)(md + col + 4) * 0.03125f;
                    f32x4 xa, xb; unpack8(*(const u32x4*)(X1 + t * 1024 + col), xa, xb);
                    const f32x4 x0 = xa + ga * acc[ai][bj][m][0], x1 = xb + gb * acc[ai][bj][m][1];
                    ss += (x0[0] * x0[0] + x0[1] * x0[1]) + (x0[2] * x0[2] + x0[3] * x0[3]) + (x1[0] * x1[0] + x1[1] * x1[1]) + (x1[2] * x1[2] + x1[3] * x1[3]); }
                ss += __shfl_xor(ss, 16); ss += __shfl_xor(ss, 32);
                if (fq == 0) st4f(SSQ + t * 16 + pn_ * 4 + wc, ss);
                asm volatile("" ::: "memory"); }
        asm volatile("s_waitcnt vmcnt(0)" ::: "memory");
        unsigned* pc = CNT + (128 + pm_) * 16;
        if ((fr_ | fq) == 0) __hip_atomic_fetch_add(pc, 1u, __ATOMIC_RELAXED, __HIP_MEMORY_SCOPE_AGENT);
        { unsigned spins = 0;
          while ((unsigned)__builtin_amdgcn_readfirstlane(__hip_atomic_load(pc, __ATOMIC_RELAXED, __HIP_MEMORY_SCOPE_AGENT)) < 32u) { __builtin_amdgcn_s_sleep(40); if (++spins > (1u << 19)) break; } }
        __builtin_amdgcn_fence(__ATOMIC_ACQUIRE, "agent"); asm volatile("s_waitcnt vmcnt(0)" ::: "memory");
        asm volatile("" : "+s"(pm_), "+s"(pn_), "+v"(fr_));
#pragma unroll
        for (int ai = 0; ai < 2; ++ai)
#pragma unroll
            for (int m = 0; m < 3; ++m) { const size_t t = (size_t)pm_ * 192 + 96 * ai + 48 * wr + 16 * m + fr_;
                const float* md2 = MOD + mod_of(t) * 6144 + 5 * 1024;
                const f32x4* sp = (const f32x4*)(SSQ + t * 16); const f32x4 q4 = (sp[0] + sp[1]) + (sp[2] + sp[3]);
                const float r = 1.0f / sqrtf(((q4[0] + q4[1]) + (q4[2] + q4[3])) * (1.0f / 1024.0f) + EPS);
#pragma unroll
                for (int bj = 0; bj < 2; ++bj) { const int col = pn_ * 256 + 128 * bj + 32 * wc + 8 * fq;
                    f32x4 xa, xb; unpack8(*(const u32x4*)(X1 + t * 1024 + col), xa, xb);
                    const f32x4 x0 = xa + *(const f32x4*)(md2 + col) * 0.03125f * acc[ai][bj][m][0], x1 = xb + *(const f32x4*)(md2 + col + 4) * 0.03125f * acc[ai][bj][m][1];
                    *(f32x4*)(OUT + t * 1024 + col) = x0 * r * *(const f32x4*)(fing + col);
                    *(f32x4*)(OUT + t * 1024 + col + 4) = x1 * r * *(const f32x4*)(fing + col + 4); }
                asm volatile("" ::: "memory"); }
    }
};


struct GF2 {
    static constexpr bool PERM = true, WAITS = false, SIGNALS = false; static constexpr bool FP8 = false; static constexpr bool WAIT2X = false; static constexpr int MH = 4, SUBS = 1, K = 256; static constexpr size_t HSA = 128 * 512, HSB = 128 * 512;
    const char* D1; const char* XS; const float* TW; bf16_t* Y1;
    __device__ __forceinline__ unsigned offA(int R) const { return (unsigned)R * 512u; }
    __device__ __forceinline__ unsigned offB(int R) const { return (unsigned)R * 512u; }
    __device__ __forceinline__ void unit(int j, Unit& u) const { u.pm = 0; u.pn = j; u.A = D1; u.B = XS + (size_t)j * 256 * 512; }
    __device__ __forceinline__ void epi(EPI_ARGS) const {
        const float* tw = TW; int fr2 = fr; asm volatile("" : "+s"(tw), "+v"(fr2));
#pragma unroll
        for (int bj = 0; bj < 2; ++bj) { const int combo = 4 * u.pn + 2 * bj + (wc >> 1), s = combo & 1, gq = 2 * (combo >> 1) + wr, la0 = 32 * (wc & 1) + 8 * fq;
#pragma unroll
            for (int m = 0; m < 4; ++m) { const int kb = 16 * m + fr2;
                const f32x4* tp = (const f32x4*)(tw + (size_t)(kb * 64 + la0) * 2);
                const f32x4 t0 = tp[0], t1 = tp[1], t2 = tp[2], t3 = tp[3];
                const f32x4 r0 = acc[0][bj][m][0], r1 = acc[0][bj][m][1], i0 = acc[1][bj][m][0], i1 = acc[1][bj][m][1];
                f32x4 pr0, pr1, pi0, pi1;
                pr0[0] = r0[0] * t0[0] + i0[0] * t0[1]; pi0[0] = i0[0] * t0[0] - r0[0] * t0[1];
                pr0[1] = r0[1] * t0[2] + i0[1] * t0[3]; pi0[1] = i0[1] * t0[2] - r0[1] * t0[3];
                pr0[2] = r0[2] * t1[0] + i0[2] * t1[1]; pi0[2] = i0[2] * t1[0] - r0[2] * t1[1];
                pr0[3] = r0[3] * t1[2] + i0[3] * t1[3]; pi0[3] = i0[3] * t1[2] - r0[3] * t1[3];
                pr1[0] = r1[0] * t2[0] + i1[0] * t2[1]; pi1[0] = i1[0] * t2[0] - r1[0] * t2[1];
                pr1[1] = r1[1] * t2[2] + i1[1] * t2[3]; pi1[1] = i1[1] * t2[2] - r1[1] * t2[3];
                pr1[2] = r1[2] * t3[0] + i1[2] * t3[1]; pi1[2] = i1[2] * t3[0] - r1[2] * t3[1];
                pr1[3] = r1[3] * t3[2] + i1[3] * t3[3]; pi1[3] = i1[3] * t3[2] - r1[3] * t3[3];
                const size_t base = ((((size_t)(s * 512 + gq) * 16 + (kb >> 2)) * 4 + (kb & 3)) * 2) * 64 + la0;
                st16(Y1 + base, pack8(pr0, pr1)); st16(Y1 + base + 64, pack8(pi0, pi1)); asm volatile("" ::: "memory"); } }
    }
};
struct GSA {
    static constexpr bool PERM = false, WAITS = false, SIGNALS = false; static constexpr bool FP8 = false; static constexpr bool WAIT2X = false; static constexpr int MH = 4, SUBS = 1, K = 256; static constexpr size_t HSA = 128 * 1024, HSB = 128 * 512;
    const char* UH; const char* SF; float* SST;
    __device__ __forceinline__ unsigned offA(int R) const { return (unsigned)R * 1024u; }
    __device__ __forceinline__ unsigned offB(int R) const { return (unsigned)R * 512u; }
    __device__ __forceinline__ void unit(int j, Unit& u) const { u.pn = (j * 171) >> 9; u.pm = j - 3 * u.pn; u.A = UH + (size_t)(u.pn * NCH + 256 * u.pm) * 1024; u.B = SF + (size_t)u.pn * 256 * 512; }
    __device__ __forceinline__ void epi(EPI_ARGS) const {
#pragma unroll
        for (int ai = 0; ai < 2; ++ai)
#pragma unroll
            for (int m = 0; m < 4; ++m) { const int chunk = 256 * u.pm + 128 * ai + 64 * wr + 16 * m + fr;
#pragma unroll
                for (int bj = 0; bj < 2; ++bj) { float* d = SST + (size_t)(u.pn * NCH + chunk) * 256 + 128 * bj + 32 * wc + 4 * fq;
                    st16f(d, acc[ai][bj][m][0]); st16f(d + 16, acc[ai][bj][m][1]); } }
    }
};
struct GF3s {
    static constexpr bool PERM = true, WAITS = false, SIGNALS = false; static constexpr bool FP8 = false; static constexpr bool WAIT2X = false; static constexpr int MH = 4, SUBS = 1, K = 512; static constexpr size_t HSA = 128 * 1024, HSB = 8 * 1024;
    const char* D2; const char* Y1; bf16_t* YF;
    __device__ __forceinline__ unsigned offA(int R) const { return (unsigned)R * 1024u; }
    __device__ __forceinline__ unsigned offB(int R) const { return (unsigned)((R & 15) * 16 + (R >> 4)) * 1024u; }
    __device__ __forceinline__ void unit(int j, Unit& u) const { u.pm = j >> 5; u.pn = 16 * (j & 31); u.A = D2; u.B = Y1 + (size_t)((u.pm * 512 + u.pn) * 16) * 1024; }
    __device__ __forceinline__ void epi(EPI_ARGS) const {
#pragma unroll
        for (int ai = 0; ai < 2; ++ai)
#pragma unroll
            for (int m = 0; m < 4; ++m) { const int mu2 = 2 * ai + wr, ka = 16 * m + fr;
#pragma unroll
                for (int bj = 0; bj < 2; ++bj) { const int c0 = 128 * bj + 32 * wc + 8 * fq, kap = c0 >> 4, qi0 = c0 & 15;
                    const int k = 64 * ka + 4 * kap + mu2;
                    st16(YF + (size_t)(NTP + 4096 * u.pm + k) * 512 + u.pn + qi0, pack8(acc[ai][bj][m][0], acc[ai][bj][m][1])); } }
    }
};
struct GF3p {
    static constexpr bool PERM = true, WAITS = false, SIGNALS = false; static constexpr bool FP8 = false; static constexpr bool WAIT2X = false; static constexpr int MH = 4, SUBS = 1, K = 512; static constexpr size_t HSA = 128 * 1024, HSB = 128 * 1024;
    const char* DP; const char* XP; bf16_t* YF;
    __device__ __forceinline__ unsigned offA(int R) const { return (unsigned)R * 1024u; }
    __device__ __forceinline__ unsigned offB(int R) const { return (unsigned)R * 1024u; }
    __device__ __forceinline__ void unit(int j, Unit& u) const { u.pm = 0; u.pn = j; u.A = DP; u.B = XP + (size_t)j * 256 * 1024; }
    __device__ __forceinline__ void epi(EPI_ARGS) const {
#pragma unroll
        for (int ai = 0; ai < 2; ++ai)
#pragma unroll
            for (int m = 0; m < 4; ++m) { const int k = 128 * ai + 64 * wr + 16 * m + fr;
#pragma unroll
                for (int bj = 0; bj < 2; ++bj) { const int xr = 256 * u.pn + 128 * bj + 32 * wc + 8 * fq, b = xr >> 9, gq = xr & 511;
                    st16(YF + (size_t)(256 * b + k) * 512 + gq, pack8(acc[ai][bj][m][0], acc[ai][bj][m][1])); } }
    }
};
struct GSC {
    static constexpr bool PERM = true, WAITS = false, SIGNALS = false; static constexpr bool FP8 = false; static constexpr bool WAIT2X = false; static constexpr int MH = 4, SUBS = 1, K = 512; static constexpr size_t HSA = 128 * 1024, HSB = 128 * 1024;
    const char* UH; const char* ME; bf16_t* ZB;
    __device__ __forceinline__ unsigned offA(int R) const { return (unsigned)R * 1024u; }
    __device__ __forceinline__ unsigned offB(int R) const { return (unsigned)R * 1024u; }
    __device__ __forceinline__ void unit(int j, Unit& u) const { u.pn = (j * 171) >> 9; u.pm = j - 3 * u.pn; u.A = UH + (size_t)(u.pn * NCH + 256 * u.pm) * 1024; u.B = ME + (size_t)u.pn * 256 * 1024; }
    __device__ __forceinline__ void epi(EPI_ARGS) const {
#pragma unroll
        for (int ai = 0; ai < 2; ++ai)
#pragma unroll
            for (int m = 0; m < 4; ++m) { const int chunk = 256 * u.pm + 128 * ai + 64 * wr + 16 * m + fr;
#pragma unroll
                for (int bj = 0; bj < 2; ++bj) { const int c0 = 128 * bj + 32 * wc + 8 * fq, i = c0 >> 4, h0 = c0 & 15;
                    f32x4 a = acc[ai][bj][m][0], b = acc[ai][bj][m][1];
#pragma unroll
                    for (int q = 0; q < 4; ++q) { a[q] = gelu_tanh(a[q]); b[q] = gelu_tanh(b[q]); }
                    st16(ZB + (size_t)(16 * chunk + i) * 512 + 16 * u.pn + h0, pack8(a, b)); } }
    }
};

struct Params {
    const float* in[27];
    float* out;
    unsigned char* wsp;
    int never; int pad;
};

__device__ __forceinline__ void transpose_item(const float* W, int ldw, int n0, int k0, bf16_t* WT, int drow, int Kd, LAS float* scr, int lane) {
    float tv[32];
#pragma unroll
    for (int i = 0; i < 32; ++i) tv[i] = W[(size_t)(k0 + 2 * i + (lane >> 5)) * ldw + n0 + (lane & 31)];
#pragma unroll
    for (int i = 0; i < 32; ++i) scr[(2 * i + (lane >> 5)) * 33 + (lane & 31)] = tv[i];
    asm volatile("s_waitcnt lgkmcnt(0)" ::: "memory");
    const int c = lane & 7;
#pragma unroll
    for (int jj = 0; jj < 4; ++jj) { const int n = (lane >> 3) + 8 * jj; const LAS float* s = scr + (8 * c) * 33 + n;
        u32x4 o; o.x = cvt_pk_bf16(s[0 * 33], s[1 * 33]); o.y = cvt_pk_bf16(s[2 * 33], s[3 * 33]); o.z = cvt_pk_bf16(s[4 * 33], s[5 * 33]); o.w = cvt_pk_bf16(s[6 * 33], s[7 * 33]);
        st16(WT + (size_t)(drow + n) * Kd + k0 + 8 * c, o); }
    asm volatile("s_waitcnt lgkmcnt(0)" ::: "memory");
}

__device__ __forceinline__ void transpose_item_fp8(const float* W, int ldw, int n0, int k0, unsigned char* WT8, int drow, int Kd, float scale, LAS float* scr, int lane) {
    float tv[32];
#pragma unroll
    for (int i = 0; i < 32; ++i) tv[i] = W[(size_t)(k0 + 2 * i + (lane >> 5)) * ldw + n0 + (lane & 31)];
#pragma unroll
    for (int i = 0; i < 32; ++i) scr[(2 * i + (lane >> 5)) * 33 + (lane & 31)] = tv[i] * scale;
    asm volatile("s_waitcnt lgkmcnt(0)" ::: "memory");
    const int c = lane & 7;
#pragma unroll
    for (int jj = 0; jj < 4; ++jj) { const int n = (lane >> 3) + 8 * jj; const LAS float* s = scr + (8 * c) * 33 + n;
        st8(WT8 + (size_t)(drow + n) * Kd + k0 + 8 * c, pack8_fp8((f32x4){s[0 * 33], s[1 * 33], s[2 * 33], s[3 * 33]}, (f32x4){s[4 * 33], s[5 * 33], s[6 * 33], s[7 * 33]})); }
    asm volatile("s_waitcnt lgkmcnt(0)" ::: "memory");
}

__global__ void __launch_bounds__(512, 2) fwd_kernel(Params P) {
    extern __shared__ __attribute__((aligned(16))) unsigned char lds_raw[];
    LAS unsigned char* lds = (LAS unsigned char*)lds_raw;
    cg::grid_group grid = cg::this_grid();
    if (P.never) grid.sync();
    if (threadIdx.x < 2) ((volatile LAS unsigned*)(lds + 8 * HTB + 16384 - 16))[threadIdx.x] = 0u;
    if (PROBE_MASK != 0 && threadIdx.x == 0) ((volatile LAS unsigned long long*)(lds + 8 * HTB + 16384 - 32))[0] = __builtin_amdgcn_s_memrealtime();
    __syncthreads();
    (void)xcd_barrier_post((unsigned*)(P.wsp + WS_BAR), (volatile LAS unsigned*)(lds + 8 * HTB + 16384 - 16));
#define GRID_SYNC1() do { asm volatile("s_waitcnt vmcnt(0) lgkmcnt(0)" ::: "memory"); XcdBarrier _xb; _xb.bar = (unsigned*)(P.wsp + WS_BAR); _xb.x = xb_xcc_id(); _xb.st = (volatile LAS unsigned*)(lds + 8 * HTB + 16384 - 16); xcd_barrier(_xb); } while (0)
#ifndef REP_SYNC
#define REP_SYNC 1
#endif
#define GRID_SYNC_N(n) do { if ((PROBE_MASK >> (n)) & 1) { if (threadIdx.x == 0) { volatile LAS unsigned long long* tp = (volatile LAS unsigned long long*)(lds + 8 * HTB + 16384 - 32); const unsigned long long t0 = tp[0], t1 = __builtin_amdgcn_s_memrealtime(); \
        while (__builtin_amdgcn_s_memrealtime() < 2 * t1 - t0) __builtin_amdgcn_s_sleep(8); } } \
    GRID_SYNC1(); \
    if (PROBE_MASK != 0) { if (threadIdx.x == 0) { volatile LAS unsigned long long* tp = (volatile LAS unsigned long long*)(lds + 8 * HTB + 16384 - 32); tp[0] = __builtin_amdgcn_s_memrealtime(); } } } while (0)
#define FRESH_IDS int tid = threadIdx.x; asm volatile("" : "+v"(tid)); const int lane = tid & 63, wave = __builtin_amdgcn_readfirstlane(tid >> 6); \
    const int gw = blockIdx.x * 8 + wave, NGW = gridDim.x * 8; (void)lane; (void)gw; (void)NGW;
#define ws (P.wsp)
#define x_prompt (P.in[0])
#define x_sample (P.in[1])
#define state_s5 (P.in[2])
#define cvec (P.in[3])
#define c_ctx (P.in[4])
#define norm1_g (P.in[5])
#define norm2_g (P.in[6])
#define w_ada (P.in[7])
#define b_ada (P.in[8])
#define w_in (P.in[9])
#define lam_re (P.in[10])
#define lam_im (P.in[11])
#define log_step (P.in[12])
#define b_re (P.in[13])
#define b_im (P.in[14])
#define c_re (P.in[15])
#define c_im (P.in[16])
#define s5_d (P.in[17])
#define w_glu (P.in[18])
#define b_glu (P.in[19])
#define w_ps (P.in[20])
#define w_pf (P.in[21])
#define w_o (P.in[22])
#define w_g (P.in[23])
#define w_u (P.in[24])
#define w_d (P.in[25])
#define fin_g (P.in[26])
#define CTL ((unsigned*)(ws + WS_CTL))
#define MOD ((float*)(ws + WS_MOD))
#define SVGU ((float*)(ws + WS_SVGU))
#define MODP ((float*)(ws + WS_MODP))
#define SSQ2 ((float*)(ws + WS_SSQ2))
#define SSQ3 ((float*)(ws + WS_SSQ3))
#define W1T ((bf16_t*)(ws + WS_W1T))
#define WFT ((bf16_t*)(ws + WS_WFT))
#define WGLU ((bf16_t*)(ws + WS_WGLU))
#define WPS ((bf16_t*)(ws + WS_WPS))
#define WPF ((bf16_t*)(ws + WS_WPF))
#define WO ((bf16_t*)(ws + WS_WO))
#define WGU ((bf16_t*)(ws + WS_WGU))
#define WD ((bf16_t*)(ws + WS_WD))
#define SG ((bf16_t*)(ws + WS_R1))
#define X1 ((bf16_t*)(ws + WS_R1))
#define UH ((bf16_t*)(ws + WS_R3))
#define A2B ((bf16_t*)(ws + WS_R3))
#define T1 ((float*)(ws + WS_R3))
#define XS ((bf16_t*)(ws + WS_R4))
#define XP ((bf16_t*)(ws + WS_XP))
#define FF ((bf16_t*)(ws + WS_R4))
#define ZB ((bf16_t*)(ws + WS_R5))
#define YS ((bf16_t*)(ws + WS_YS))
#define YF ((bf16_t*)(ws + WS_YF))
#define HB ((bf16_t*)(ws + WS_R2))
#define YACC ((float*)(ws + WS_R2))
#define MB ((bf16_t*)(ws + WS_R2))
#define SST ((float*)(ws + WS_R2))
#define Y1B ((bf16_t*)(ws + WS_R5))
#define SFM ((bf16_t*)(ws + WS_SF))
#define MEM ((bf16_t*)(ws + WS_ME))
#define KKM ((float*)(ws + WS_KK))
#define A16M ((float*)(ws + WS_A16))
#define D1M ((bf16_t*)(ws + WS_D1))
#define D2M ((bf16_t*)(ws + WS_D2))
#define DPM ((bf16_t*)(ws + WS_DP))
#define TWM ((float*)(ws + WS_TW))
#define OUT (P.out)

    {
    {
        FRESH_IDS
        if (blockIdx.x < 128) {
            LAS float* tile = (LAS float*)lds;
            LAS float* cs = tile + 32 * 132; LAS float* sn = cs + 128;
            const int gg = blockIdx.x >> 5, k0 = 32 * (blockIdx.x & 31);
            for (int idx = tid; idx < 32 * 32; idx += 512) { const int row = idx >> 5, c4 = idx & 31;
                const f32x4 v = *(const f32x4*)(w_in + (size_t)(k0 + row) * 3072 + 512 + 128 * gg + 4 * c4);
                *(LAS f32x4*)(tile + row * 132 + 4 * c4) = v; }
            if (tid < 128) { float s, c; sincos_frac(tid, 128, s, c); cs[tid] = c * 0.08838834764831845f; sn[tid] = s * 0.08838834764831845f; }
            __syncthreads();
            const int n = tid & 255, part = n >> 7, q = n & 127, kh = tid >> 8;
            float a[16];
#pragma unroll
            for (int i = 0; i < 16; ++i) a[i] = 0.f;
            const LAS float* tb = part ? sn : cs;
            for (int c = 0; c < 128; c += 4) {
                const float r0 = tb[(q * c) & 127], r1 = tb[(q * (c + 1)) & 127], r2 = tb[(q * (c + 2)) & 127], r3 = tb[(q * (c + 3)) & 127];
#pragma unroll
                for (int i = 0; i < 16; ++i) { const f32x4 w = *(const LAS f32x4*)(tile + (16 * kh + i) * 132 + c); a[i] += (w[0] * r0 + w[1] * r1) + (w[2] * r2 + w[3] * r3); }
            }
            bf16_t* dst = WFT + (size_t)(gg * 256 + n) * 1024 + k0 + 16 * kh;
            u32x4 o0, o1; o0.x = cvt_pk_bf16(a[0], a[1]); o0.y = cvt_pk_bf16(a[2], a[3]); o0.z = cvt_pk_bf16(a[4], a[5]); o0.w = cvt_pk_bf16(a[6], a[7]);
            o1.x = cvt_pk_bf16(a[8], a[9]); o1.y = cvt_pk_bf16(a[10], a[11]); o1.z = cvt_pk_bf16(a[12], a[13]); o1.w = cvt_pk_bf16(a[14], a[15]);
            st16(dst, o0); st16(dst + 8, o1);
            __syncthreads();
        }
        else if (blockIdx.x < 192) {
            LAS float* Wre = (LAS float*)lds; LAS float* Wim = Wre + 16384;
            LAS float* Cre = Wim + 16384; LAS float* Cim = Cre + 16 * 65;
            const int td = blockIdx.x - 128, gg = td >> 1, d = td & 1;
            {
                const int p = tid & 63, hq = tid >> 6, pi = (d * 32 + gg) * 64 + p;
                const float lr = lam_re[pi], li = lam_im[pi], step = __expf(log_step[d * 32 + gg]);
                double sd, cd; sincos_d((double)(li * step), sd, cd);
                const float mag = __expf(lr * step), are = mag * (float)cd, aim = mag * (float)sd;
                const float nr = are - 1.0f, ni = aim, den = lr * lr + li * li, fr_ = (nr * lr + ni * li) / den, fi_ = (ni * lr - nr * li) / den;
                float wr_[2], wi_[2], cr_[2], ci_[2];
#pragma unroll
                for (int e = 0; e < 2; ++e) { const int h = 2 * hq + e; const float br = b_re[(size_t)pi * 16 + h], bi = b_im[(size_t)pi * 16 + h];
                    wr_[e] = fr_ * br - fi_ * bi; wi_[e] = fr_ * bi + fi_ * br;
                    cr_[e] = c_re[((size_t)(d * 32 + gg) * 16 + h) * 64 + p]; ci_[e] = c_im[((size_t)(d * 32 + gg) * 16 + h) * 64 + p];
                    Cre[h * 65 + p] = cr_[e]; Cim[h * 65 + p] = ci_[e]; }
                float pr = are, pim = aim;
#pragma unroll
                for (int m = 0; m < 16; ++m) {
#pragma unroll
                    for (int e = 0; e < 2; ++e) { const int h = 2 * hq + e; Wre[(m * 64 + p) * 16 + h] = wr_[e]; Wim[(m * 64 + p) * 16 + h] = wi_[e];
                        const float nwr = are * wr_[e] - aim * wi_[e], nwi = are * wi_[e] + aim * wr_[e]; wr_[e] = nwr; wi_[e] = nwi;
                        const float vr = cr_[e] * pr - ci_[e] * pim, vi = cr_[e] * pim + ci_[e] * pr;
                        const int irow = d ? 15 - m : m;
                        float* dst = (float*)(MEM + ((size_t)(gg * 256 + 16 * irow + h) * 512 + 256 + d * 128 + 2 * p));
                        st4f(dst, __uint_as_float(cvt_pk_bf16(vr, -vi))); }
                    if (m == 15 && hq == 0) { float* a16 = A16M + (size_t)((gg * 2 + d) * 64 + p) * 2; st4f(a16, pr); st4f(a16 + 1, pim); }
                    const float npr = pr * are - pim * aim, npi = pr * aim + pim * are; pr = npr; pim = npi;
                }
            }
            __syncthreads();
            {
                const int nl = tid >> 2, p = nl >> 1, ri = nl & 1, qt = tid & 3;
                const LAS float* Wsrc = ri ? Wim : Wre;
#pragma unroll
                for (int e = 0; e < 4; ++e) { const int jj = 4 * qt + e, m = d ? jj : 15 - jj;
                    const LAS f32x4* wp = (const LAS f32x4*)(Wsrc + (m * 64 + p) * 16);
                    bf16_t* dst = SFM + ((size_t)(gg * 256 + d * 128 + nl) * 256 + 16 * jj);
                    st16(dst, pack8(wp[0], wp[1])); st16(dst + 8, pack8(wp[2], wp[3])); }
            }
            {
                const int m = tid >> 5, hp = (tid >> 1) & 15, hh = (tid & 1) * 8;
                f32x4 a0 = {0.f, 0.f, 0.f, 0.f}, a1 = a0;
                for (int p = 0; p < 64; ++p) { const float cr = Cre[hp * 65 + p], ci = Cim[hp * 65 + p];
                    const LAS f32x4* wrp = (const LAS f32x4*)(Wre + (m * 64 + p) * 16 + hh); const LAS f32x4* wip = (const LAS f32x4*)(Wim + (m * 64 + p) * 16 + hh);
                    a0 += wrp[0] * cr - wip[0] * ci; a1 += wrp[1] * cr - wip[1] * ci; }
                float* dst = KKM + ((size_t)((gg * 2 + d) * 16 + m) * 256 + hp * 16 + hh);
                st16f(dst, a0); st16f(dst + 4, a1);
            }
            __syncthreads();
        }
        else {
            const int gt = (blockIdx.x - 192) * 512 + tid, ngt = (gridDim.x - 192) * 512;
            for (int tk = gt; tk < 8192 + 16384 + 16384 + 2048; tk += ngt) {
                float v[8];
                if (tk < 8192) {
                    const int r = tk >> 5, k0 = (tk & 31) * 8, pp = r >> 7, mup = (r >> 6) & 1, kb = r & 63, mu = k0 >> 7, part = (k0 >> 6) & 1, lb0 = k0 & 63;
#pragma unroll
                    for (int e = 0; e < 8; ++e) { float s, c; sincos_frac(kb * (lb0 + e), 64, s, c);
                        const float val = (pp == 0) ? (part == 0 ? c : -s) : (part == 0 ? -s : -c); v[e] = (mu == mup) ? val * 0.125f : 0.f; }
                    st16(D1M + (size_t)r * 256 + k0, pack8((f32x4){v[0], v[1], v[2], v[3]}, (f32x4){v[4], v[5], v[6], v[7]}));
                } else if (tk < 8192 + 16384) {
                    const int t2 = tk - 8192, r = t2 >> 6, k0 = (t2 & 63) * 8, mu2 = r >> 6, ka = r & 63, mu2p = k0 >> 7, part = (k0 >> 6) & 1, la0 = k0 & 63;
#pragma unroll
                    for (int e = 0; e < 8; ++e) { float s, c; sincos_frac(ka * (la0 + e), 64, s, c); v[e] = (mu2 == mu2p) ? (part == 0 ? c : s) * 0.125f : 0.f; }
                    st16(D2M + (size_t)r * 512 + k0, pack8((f32x4){v[0], v[1], v[2], v[3]}, (f32x4){v[4], v[5], v[6], v[7]}));
                } else if (tk < 8192 + 32768) {
                    const int t2 = tk - 8192 - 16384, r = t2 >> 6, k0 = (t2 & 63) * 8, part = k0 >> 8, l0 = k0 & 255;
#pragma unroll
                    for (int e = 0; e < 8; ++e) { float s, c; sincos_frac(r * (l0 + e), 256, s, c); v[e] = (part == 0 ? c : -s) * 0.0625f; }
                    st16(DPM + (size_t)r * 512 + k0, pack8((f32x4){v[0], v[1], v[2], v[3]}, (f32x4){v[4], v[5], v[6], v[7]}));
                } else {
                    const int t2 = tk - 8192 - 32768, kb = t2 >> 5, la0 = (t2 & 31) * 2;
                    float s0, c0, s1, c1; sincos_frac(kb * la0, 4096, s0, c0); sincos_frac(kb * (la0 + 1), 4096, s1, c1);
                    st16f(TWM + (size_t)(kb * 64 + la0) * 2, (f32x4){c0, s0, c1, s1});
                }
            }
        }
        __syncthreads();
        if (blockIdx.x >= 160) {
            LAS float* sl = (LAS float*)lds;
            LAS float* red = sl + 3 * 1024;
            for (int k = tid; k < 1024; k += 512) { const float a = c_ctx[k], b = cvec[k], c = cvec[1024 + k]; sl[k] = a * sigm(a); sl[1024 + k] = b * sigm(b); sl[2048 + k] = c * sigm(c); }
            __syncthreads();
            const int cgp = blockIdx.x - 160, k0 = wave * 128;
            const float* wp = w_ada + (size_t)k0 * 6144 + cgp * 64 + lane;
            float a0 = 0.f, a1 = 0.f, a2 = 0.f;
            for (int kb = 0; kb < 128; kb += 32) {
                float w[32];
#pragma unroll
                for (int e = 0; e < 32; ++e) w[e] = wp[(size_t)(kb + e) * 6144];
#pragma unroll
                for (int e = 0; e < 32; ++e) { const int k = k0 + kb + e; a0 += w[e] * sl[k]; a1 += w[e] * sl[1024 + k]; a2 += w[e] * sl[2048 + k]; }
            }
            red[(wave * 3 + 0) * 64 + lane] = a0; red[(wave * 3 + 1) * 64 + lane] = a1; red[(wave * 3 + 2) * 64 + lane] = a2;
            __syncthreads();
            if (tid < 192) { const int mi = tid >> 6, c = tid & 63; float s = b_ada[cgp * 64 + c];
#pragma unroll
                for (int w8 = 0; w8 < 8; ++w8) s += red[(w8 * 3 + mi) * 64 + c];
                st4f(MOD + mi * 6144 + cgp * 64 + c, s); }
            __syncthreads();
        }
        LAS float* scr = (LAS float*)(lds + 32768 + wave * 8704);
        for (int it = gw; it < 1920; it += NGW) {
            int r = it;
            if (r < 256) { const int kb = r / 16, nb = r % 16; transpose_item(w_in, 3072, 32 * nb, 64 * kb, W1T, 32 * nb, 1024, scr, lane); continue; } r -= 256;
            if (r < 1024) { const int kb = r / 64, nb = r % 64; transpose_item(w_in, 3072, 1024 + 32 * nb, 64 * kb, W1T, 512 + 32 * nb, 1024, scr, lane); continue; } r -= 1024;
            if (r < 128) { const int kb = r / 16, nb = r % 16; transpose_item(w_glu, 512, 32 * nb, 64 * kb, WGLU, 32 * nb, 512, scr, lane); continue; } r -= 128;
            if (r < 256) { const int kb = r / 32, nb = r % 32; transpose_item(w_ps, 1024, 32 * nb, 64 * kb, WPS, 32 * nb, 512, scr, lane); continue; } r -= 256;
            { const int kb = r / 32, nb = r % 32; transpose_item(w_pf, 1024, 32 * nb, 64 * kb, WPF, 32 * nb, 512, scr, lane); }
        }
    }
    GRID_SYNC_N(0);
    {
        FRESH_IDS
        for (int t0 = gw; t0 < NT; t0 += 3 * NGW) {
            f32x4 v[3][4];
#pragma unroll
            for (int rr = 0; rr < 3; ++rr) { const int t = t0 + rr * NGW;
                if (t < NT) { const float* xr = t < NTP ? x_prompt + (size_t)t * 1024 : x_sample + (size_t)(t - NTP) * 1024;
#pragma unroll
                    for (int jx = 0; jx < 4; ++jx) v[rr][jx] = *(const f32x4*)(xr + 8 * lane + 512 * (jx >> 1) + 4 * (jx & 1)); } }
#pragma unroll
            for (int rr = 0; rr < 3; ++rr) { const int t = t0 + rr * NGW;
                if (t < NT) {
                    const int mi = t < NTP ? 0 : (t < NTP + 4096 ? 1 : 2);
                    const float* md = MOD + mi * 6144;
                    float s = 0.f;
#pragma unroll
                    for (int jx = 0; jx < 4; ++jx) s += (v[rr][jx][0] * v[rr][jx][0] + v[rr][jx][1] * v[rr][jx][1]) + (v[rr][jx][2] * v[rr][jx][2] + v[rr][jx][3] * v[rr][jx][3]);
                    const float r = 1.0f / sqrtf(wave_sum(s) * (1.0f / 1024.0f) + EPS);
                    f32x4 h[4];
#pragma unroll
                    for (int jx = 0; jx < 4; ++jx) { const int col = 8 * lane + 512 * (jx >> 1) + 4 * (jx & 1);
                        const f32x4 gs = *(const f32x4*)(norm1_g + col) * (*(const f32x4*)(md + 1024 + col) + 1.0f), sh = *(const f32x4*)(md + col);
                        h[jx] = v[rr][jx] * r * gs + sh; }
                    st16(HB + (size_t)t * 1024 + 8 * lane, pack8(h[0], h[1])); st16(HB + (size_t)t * 1024 + 512 + 8 * lane, pack8(h[2], h[3])); } }
        }
        for (int idx = blockIdx.x * 512 + tid; idx < 131072; idx += gridDim.x * 512) {
            const int gg = idx >> 12, r = (idx >> 4) & 255, jj = idx & 15, i = r >> 4, hp = r & 15;
            f32x4 v0 = {0.f, 0.f, 0.f, 0.f}, v1 = v0, v2 = v0, v3 = v0;
            if (jj <= i) { const f32x4* kp = (const f32x4*)(KKM + ((size_t)((gg * 2 + 0) * 16 + (i - jj)) * 256 + hp * 16)); v0 += kp[0]; v1 += kp[1]; v2 += kp[2]; v3 += kp[3]; }
            if (jj >= i) { const f32x4* kp = (const f32x4*)(KKM + ((size_t)((gg * 2 + 1) * 16 + (jj - i)) * 256 + hp * 16)); v0 += kp[0]; v1 += kp[1]; v2 += kp[2]; v3 += kp[3]; }
            if (jj == i) { const float dv = s5_d[16 * gg + hp];
#pragma unroll
                for (int e = 0; e < 4; ++e) { v0[e] += (hp == e) ? dv : 0.f; v1[e] += (hp == 4 + e) ? dv : 0.f; v2[e] += (hp == 8 + e) ? dv : 0.f; v3[e] += (hp == 12 + e) ? dv : 0.f; } }
            bf16_t* dst = MEM + ((size_t)(gg * 256 + r) * 512 + 16 * jj);
            st16(dst, pack8(v0, v1)); st16(dst + 8, pack8(v2, v3));
        }
    }
    GRID_SYNC_N(1);
    }
#if DBG_STOP == 2
    { FRESH_IDS
      for (size_t i = (size_t)blockIdx.x * 512 + tid; i < (size_t)NT * 1024; i += (size_t)gridDim.x * 512) { const size_t c = i & 1023; OUT[i] = bf2f(HB[i]) + 0.25f * (bf2f(W1T[i % (2560 * 1024)]) + bf2f(WFT[i % (1024 * 1024)]) + bf2f(WGU[i % (5632 * 1024)]) + bf2f(WD[i % (2816 * 1024)])) + MOD[i % 18432]; (void)c; }
      for (size_t i = (size_t)blockIdx.x * 512 + tid; i < 131072; i += (size_t)gridDim.x * 512) { OUT[(size_t)NT * 1024 + i] = SVGU[i % 16896] + bf2f(WGLU[i]) + bf2f(WPS[i]) + bf2f(WPF[i]) + bf2f(WO[i]); }
      return; }
#endif
    {
    { G1a g{(const char*)HB, (const char*)W1T, UH, SG}; gemm_phase(lds, g, 0, 480);
#if REP_P1 > 1
      gemm_phase(lds, g, 0, 480);
#endif
    }
    { G1b g{(const char*)HB, (const char*)WFT, XS}; gemm_phase(lds, g, 480, 128); }
    { G1c g{(const char*)HB, (const char*)WFT, XP}; gemm_phase(lds, g, 608, 64); }
    GRID_SYNC_N(2);
    }
#if DBG_STOP == 1
    { FRESH_IDS
      for (size_t i = (size_t)blockIdx.x * 512 + tid; i < (size_t)NT * 1024; i += (size_t)gridDim.x * 512) { const size_t t = i >> 10, c = i & 1023; OUT[i] = bf2f(SG[t * 2048 + c]) + bf2f(SG[t * 2048 + 1024 + c]); }
      for (size_t i = (size_t)blockIdx.x * 512 + tid; i < 131072; i += (size_t)gridDim.x * 512) { float a = 0.f; for (int r = 0; r < 64; ++r) a += bf2f(XS[i * 64 + r]) + bf2f(XP[i * 32 + (r & 31)]); const size_t u = i * 48; const size_t row = u >> 8, cc = u & 255; a += bf2f(UH[row * 512 + cc]); OUT[(size_t)NT * 1024 + i] = a; }
      return; }
#endif
    {
    { GF2 g{(const char*)D1M, (const char*)XS, TWM, Y1B}; gemm_phase(lds, g, 0, 128); }
    { GSA g{(const char*)UH, (const char*)SFM, SST}; gemm_phase(lds, g, 128, 96); }
    GRID_SYNC_N(3);
    { GF3s g{(const char*)D2M, (const char*)Y1B, YF}; gemm_phase(lds, g, 0, 64); }
    { GF3p g{(const char*)DPM, (const char*)XP, YF}; gemm_phase(lds, g, 64, 32); }
    if (blockIdx.x >= 96) {
        FRESH_IDS
        const int nw = (gridDim.x - 96) * 8;
        for (int tk = (blockIdx.x - 96) * 8 + wave; tk < 1152; tk += nw) {
            int gg, d, nc, cbase, sidx; bool smp;
            if (tk < 128) { smp = true; sidx = tk >> 6; gg = (tk >> 1) & 31; d = tk & 1; nc = 256; cbase = 256 + 256 * sidx; }
            else { const int t2 = tk - 128; smp = false; sidx = t2 >> 6; gg = (t2 >> 1) & 31; d = t2 & 1; nc = 16; cbase = 16 * sidx; }
            const f32x2 a16 = *(const f32x2*)(A16M + (size_t)((gg * 2 + d) * 64 + lane) * 2);
            float hre = 0.f, him = 0.f;
            if (smp) { hre = state_s5[(((size_t)sidx * 2 + d) * 2 + 0) * 2048 + gg * 64 + lane]; him = state_s5[(((size_t)sidx * 2 + d) * 2 + 1) * 2048 + gg * 64 + lane]; }
            const float* sp = SST + (size_t)(gg * NCH + cbase) * 256 + d * 128 + 2 * lane;
            bf16_t* hp = UH + (size_t)(gg * NCH + cbase) * 512 + 256 + d * 128 + 2 * lane;
            const int c0 = d ? nc - 1 : 0, cs = d ? -1 : 1;
            if (nc == 256) {
                f32x2 cur[32], nxt[32];
#pragma unroll
                for (int e = 0; e < 32; ++e) cur[e] = *(const f32x2*)(sp + (ptrdiff_t)(c0 + cs * e) * 256);
                for (int cb = 0; cb < 256; cb += 32) {
                    if (cb + 32 < 256) {
#pragma unroll
                        for (int e = 0; e < 32; ++e) nxt[e] = *(const f32x2*)(sp + (ptrdiff_t)(c0 + cs * (cb + 32 + e)) * 256);
                    }
#pragma unroll
                    for (int e = 0; e < 32; ++e) { const int c = c0 + cs * (cb + e);
                        st4f((float*)(hp + (ptrdiff_t)c * 512), __uint_as_float(cvt_pk_bf16(hre, him)));
                        const float nr = a16[0] * hre - a16[1] * him + cur[e][0], ni = a16[0] * him + a16[1] * hre + cur[e][1]; hre = nr; him = ni; }
#pragma unroll
                    for (int e = 0; e < 32; ++e) cur[e] = nxt[e];
                }
            } else {
                f32x2 cur[16];
#pragma unroll
                for (int e = 0; e < 16; ++e) cur[e] = *(const f32x2*)(sp + (ptrdiff_t)(c0 + cs * e) * 256);
#pragma unroll
                for (int e = 0; e < 16; ++e) { const int c = c0 + cs * e;
                    st4f((float*)(hp + (ptrdiff_t)c * 512), __uint_as_float(cvt_pk_bf16(hre, him)));
                    const float nr = a16[0] * hre - a16[1] * him + cur[e][0], ni = a16[0] * him + a16[1] * hre + cur[e][1]; hre = nr; him = ni; }
            }
            if (!smp) { float* ns = OUT + (size_t)NT * 1024 + (((size_t)sidx * 2 + d) * 2) * 2048 + gg * 64 + lane; ns[0] = hre; ns[2048] = him; }
        }
    }
    GRID_SYNC_N(4);
    { GSC g{(const char*)UH, (const char*)MEM, ZB}; gemm_phase(lds, g, 0, 96); }
    if (blockIdx.x >= 96) {
        FRESH_IDS
        LAS float* scr = (LAS float*)(lds + 32768 + wave * 8704);
        const int nw = (gridDim.x - 96) * 8;
        for (int it = (blockIdx.x - 96) * 8 + wave; it < 4736; it += nw) {
            int r = it;
            if (r < 512) { const int kb = r / 32, nb = r % 32; transpose_item(w_o, 1024, 32 * nb, 64 * kb, WO, 32 * nb, 1024, scr, lane); continue; } r -= 512;
            if (r < 1408) { const int kb = r / 88, nb = r % 88, n0 = 32 * nb; transpose_item(w_g, 2816, n0, 64 * kb, WGU, 256 * (n0 >> 7) + (n0 & 127), 1024, scr, lane); continue; } r -= 1408;
            if (r < 1408) { const int kb = r / 88, nb = r % 88, n0 = 32 * nb; transpose_item(w_u, 2816, n0, 64 * kb, WGU, 256 * (n0 >> 7) + 128 + (n0 & 127), 1024, scr, lane); continue; } r -= 1408;
            { const int kb = r / 32, nb = r % 32; transpose_item_fp8(w_d, 1024, 32 * nb, 64 * kb, (unsigned char*)WD, 32 * nb, 2816, 32.0f, scr, lane); }
        }
    }
    GRID_SYNC_N(5);
    }
    {
    { Gglu g{(const char*)ZB, (const char*)WGLU, b_glu, YS, (unsigned*)(ws + WS_CNT)}; gemm_phase(lds, g, 0, 128); }
    if (blockIdx.x >= 128) {
        FRESH_IDS
        const int nw = (gridDim.x - 128) * 8;
        for (int n = (blockIdx.x - 128) * 8 + wave; n < 5632; n += nw) {
            const u32x4 w0 = *(const u32x4*)(WGU + (size_t)n * 1024 + 16 * lane), w1 = *(const u32x4*)(WGU + (size_t)n * 1024 + 16 * lane + 8);
            f32x4 wa, wb, wc4, wd; unpack8(w0, wa, wb); unpack8(w1, wc4, wd);
            float dsum[3];
#pragma unroll
            for (int mi = 0; mi < 3; ++mi) { const float* sh = MOD + mi * 6144 + 3 * 1024 + 16 * lane;
                const f32x4 s0 = *(const f32x4*)(sh), s1 = *(const f32x4*)(sh + 4), s2 = *(const f32x4*)(sh + 8), s3 = *(const f32x4*)(sh + 12);
                const f32x4 p = wa * s0 + wb * s1 + wc4 * s2 + wd * s3; dsum[mi] = (p[0] + p[1]) + (p[2] + p[3]); }
#pragma unroll
            for (int o = 1; o < 64; o <<= 1) { dsum[0] += __shfl_xor(dsum[0], o); dsum[1] += __shfl_xor(dsum[1], o); dsum[2] += __shfl_xor(dsum[2], o); }
            if (lane < 3) st4f(SVGU + lane * 5632 + n, lane == 0 ? dsum[0] : (lane == 1 ? dsum[1] : dsum[2]));
        }
    }
    { Gproj g{(const char*)YS, (const char*)YF, (const char*)WPS, (const char*)WPF, SG, MB, (unsigned*)(ws + WS_CNT)}; gemm_phase(lds, g, 0, 256); }
    GRID_SYNC_N(7);
    { Gwo g{(const char*)MB, (const char*)WO, x_prompt, x_sample, MOD, norm2_g, X1, A2B, SSQ2}; gemm_phase(lds, g, 0, 256); }
    GRID_SYNC_N(8);
    }
    {
    { Ggu g{(const char*)A2B, (const char*)WGU, SSQ2, SVGU, FF, (unsigned*)(ws + WS_CNT)}; gemm_phase(lds, g, 0, 1408);
#if REP_P6 > 1
      gemm_phase(lds, g, 0, 1408);
#endif
    }
    }
    {
    { Gdn g{(const char*)FF, (const char*)WD, X1, MOD, OUT, SSQ3, fin_g, (unsigned*)(ws + WS_CNT)}; gemm_phase(lds, g, 0, 256);
#if REP_P7 > 1
      gemm_phase(lds, g, 0, 192);
#endif
    }
    }
}

#undef ws
#undef OUT
constexpr int LDS_BYTES = 8 * HTB + 16384;

extern "C" void kernel_launch(void* const* d_in, const int* in_sizes, int n_in, void* d_out, int out_size, void* d_ws, size_t ws_size, hipStream_t stream) {
    static int grid = 0;
    if (grid == 0) {
        int dev = 0, cus = 0, per_cu = 0;
        hipGetDevice(&dev);
        hipDeviceGetAttribute(&cus, hipDeviceAttributeMultiprocessorCount, dev);
        if (hipFuncSetAttribute((const void*)fwd_kernel, hipFuncAttributeMaxDynamicSharedMemorySize, LDS_BYTES) != hipSuccess) fprintf(stderr, "hipFuncSetAttribute failed\n");
        if (hipOccupancyMaxActiveBlocksPerMultiprocessor(&per_cu, (const void*)fwd_kernel, 512, LDS_BYTES) != hipSuccess || per_cu < 1) { fprintf(stderr, "occupancy query: %d\n", per_cu); per_cu = 1; }
        (void)hipGetLastError();
        grid = cus > 0 ? cus : 256;
        if (ws_size < WS_END) fprintf(stderr, "workspace too small: %zu < %zu\n", ws_size, (size_t)WS_END);
    }
    (void)hipMemsetAsync((char*)d_ws + WS_BAR, 0, 32768, stream);
    Params p{};
    for (int i = 0; i < 27; ++i) p.in[i] = (const float*)d_in[i];
    p.out = (float*)d_out; p.wsp = (unsigned char*)d_ws;
    void* args[] = {&p};
    hipError_t e = hipLaunchCooperativeKernel((const void*)fwd_kernel, dim3(grid), dim3(512), args, LDS_BYTES, stream);
    if (e != hipSuccess) fprintf(stderr, "cooperative launch failed: %s (grid %d)\n", hipGetErrorString(e), grid);
}
```

```cpp
#include <hip/hip_runtime.h>
#include <hip/hip_cooperative_groups.h>
#include <cstdio>
#include <cstdint>
namespace cg = cooperative_groups;

#define LAS __attribute__((address_space(3)))
typedef unsigned short bf16_t;
typedef short bf16x8 __attribute__((ext_vector_type(8)));
typedef float f32x4 __attribute__((ext_vector_type(4)));
typedef float f32x2 __attribute__((ext_vector_type(2)));
typedef unsigned u32x4 __attribute__((ext_vector_type(4)));
typedef unsigned u32x2 __attribute__((ext_vector_type(2)));
typedef int v8i __attribute__((ext_vector_type(8)));

#ifndef DBG_STOP
#define DBG_STOP 0
#endif
#ifndef PROBE_MASK
#define PROBE_MASK 0
#endif
#ifndef REP_P0
#define REP_P0 1
#endif
#ifndef REP_P1
#define REP_P1 1
#endif
#ifndef REP_X
#define REP_X 1
#endif
#ifndef REP_P6
#define REP_P6 1
#endif
#ifndef REP_P7
#define REP_P7 1
#endif
#ifndef REP_P345
#define REP_P345 1
#endif
constexpr int NT = 12288, NTP = 4096, DM = 1024, NCH = 768, DFF = 2816;
constexpr float EPS = 1e-6f;

constexpr size_t AL(size_t x) { return (x + 255) & ~(size_t)255; }
constexpr size_t WS_CTL = 0;
constexpr size_t WS_MOD = 4096;
constexpr size_t WS_SVGU = WS_MOD + AL(3 * 6144 * 4);
constexpr size_t WS_MODP = AL(WS_SVGU + 3 * 5632 * 4);
constexpr size_t WS_SSQ2 = AL(WS_MODP + 32 * 3 * 6144 * 4);
constexpr size_t WS_SSQ3 = AL(WS_SSQ2 + (size_t)NT * 16 * 4);
constexpr size_t WS_W1T = AL(WS_SSQ3 + (size_t)NT * 16 * 4);
constexpr size_t WS_WFT = WS_W1T + 2560 * 1024 * 2;
constexpr size_t WS_WGLU = WS_WFT + 1024 * 1024 * 2;
constexpr size_t WS_WPS = WS_WGLU + 512 * 512 * 2;
constexpr size_t WS_WPF = WS_WPS + 1024 * 512 * 2;
constexpr size_t WS_WO = WS_WPF + 1024 * 512 * 2;
constexpr size_t WS_WGU = WS_WO + 1024 * 1024 * 2;
constexpr size_t WS_WD = WS_WGU + (size_t)5632 * 1024 * 2;
constexpr size_t WS_R1 = AL(WS_WD + (size_t)1024 * 2816 * 2);
constexpr size_t WS_R3 = WS_R1 + (size_t)NT * 2048 * 2;
constexpr size_t WS_R4 = WS_R3 + (size_t)NT * 1024 * 2;
constexpr size_t WS_XP = WS_R4 + (size_t)16777216;
constexpr size_t WS_R5 = WS_R4 + (size_t)NT * 1024 * 2;
constexpr size_t WS_YS = WS_R5 + (size_t)NT * 512 * 2;
constexpr size_t WS_YF = WS_YS + (size_t)NT * 512 * 2;
constexpr size_t WS_R2 = WS_YF + (size_t)NT * 512 * 2;
constexpr size_t WS_SF = WS_R2 + (size_t)NT * 1024 * 2;
constexpr size_t WS_ME = WS_SF + (size_t)32 * 256 * 256 * 2;
constexpr size_t WS_KK = WS_ME + (size_t)32 * 256 * 512 * 2;
constexpr size_t WS_A16 = WS_KK + (size_t)32 * 2 * 4096 * 4;
constexpr size_t WS_D1 = WS_A16 + 32 * 2 * 64 * 8;
constexpr size_t WS_D2 = WS_D1 + 256 * 256 * 2;
constexpr size_t WS_DP = WS_D2 + 256 * 512 * 2;
constexpr size_t WS_TW = WS_DP + 256 * 512 * 2;
constexpr size_t WS_BAR = WS_TW + 64 * 64 * 8;
constexpr size_t WS_CNT = WS_BAR + 16384;
constexpr size_t WS_END = WS_CNT + 16384;

__device__ __forceinline__ unsigned cvt_pk_bf16(float lo, float hi) { unsigned r; asm volatile("v_cvt_pk_bf16_f32 %0, %1, %2" : "=v"(r) : "v"(lo), "v"(hi)); return r; }
__device__ __forceinline__ float bf2f(unsigned short b) { return __uint_as_float(((unsigned)b) << 16); }
__device__ __forceinline__ float bflo(unsigned w) { return __uint_as_float(w << 16); }
__device__ __forceinline__ float bfhi(unsigned w) { return __uint_as_float(w & 0xffff0000u); }
__device__ __forceinline__ float sigm(float x) { return __builtin_amdgcn_rcpf(1.0f + __expf(-x)); }
__device__ __forceinline__ float gelu_tanh(float x) { const float u = 0.7978845608028654f * (x + 0.044715f * x * x * x); return x * sigm(2.0f * u); }
__device__ __forceinline__ float wave_sum(float v) {
#pragma unroll
    for (int o = 1; o < 64; o <<= 1) v += __shfl_xor(v, o);
    return v;
}
__device__ __forceinline__ void st16(void* p, u32x4 v) { asm volatile("global_store_dwordx4 %0, %1, off sc1\n\ts_nop 1" :: "v"(p), "v"(v) : "memory"); }
__device__ __forceinline__ void st16f(void* p, f32x4 v) { asm volatile("global_store_dwordx4 %0, %1, off sc1\n\ts_nop 1" :: "v"(p), "v"(v) : "memory"); }
__device__ __forceinline__ void st8(void* p, u32x2 v) { asm volatile("global_store_dwordx2 %0, %1, off sc1\n\ts_nop 1" :: "v"(p), "v"(v) : "memory"); }
__device__ __forceinline__ u32x2 pack8_fp8(f32x4 a, f32x4 b) { u32x2 w; int t = __builtin_amdgcn_cvt_pk_fp8_f32(a[0], a[1], 0, false); t = __builtin_amdgcn_cvt_pk_fp8_f32(a[2], a[3], t, true); w.x = (unsigned)t;
    t = __builtin_amdgcn_cvt_pk_fp8_f32(b[0], b[1], 0, false); t = __builtin_amdgcn_cvt_pk_fp8_f32(b[2], b[3], t, true); w.y = (unsigned)t; return w; }
__device__ __forceinline__ void st4f(float* p, float v) { asm volatile("global_store_dword %0, %1, off sc1\n\ts_nop 1" :: "v"(p), "v"(v) : "memory"); }
__device__ __forceinline__ void st2(bf16_t* p, unsigned v) { asm volatile("global_store_short %0, %1, off sc1\n\ts_nop 1" :: "v"(p), "v"(v) : "memory"); }
__device__ __forceinline__ u32x4 pack8(f32x4 a, f32x4 b) { u32x4 w; w.x = cvt_pk_bf16(a[0], a[1]); w.y = cvt_pk_bf16(a[2], a[3]); w.z = cvt_pk_bf16(b[0], b[1]); w.w = cvt_pk_bf16(b[2], b[3]); return w; }
__device__ __forceinline__ void unpack8(u32x4 w, f32x4& a, f32x4& b) { a = (f32x4){bflo(w.x), bfhi(w.x), bflo(w.y), bfhi(w.y)}; b = (f32x4){bflo(w.z), bfhi(w.z), bflo(w.w), bfhi(w.w)}; }
__device__ __forceinline__ void sincos_d(double th, double& s, double& c) {
    const double k = rint(th * 0.63661977236758134308);
    const double r = fma(-k, 6.123233995736766e-17, fma(-k, 1.5707963267948966, th));
    const double x2 = r * r;
    double sp = -7.6471637318198165e-13; sp = sp * x2 + 1.6059043836821613e-10; sp = sp * x2 - 2.5052108385441719e-08; sp = sp * x2 + 2.7557319223985891e-06;
    sp = sp * x2 - 1.9841269841269841e-04; sp = sp * x2 + 8.3333333333333333e-03; sp = sp * x2 - 1.6666666666666667e-01; sp = r + r * x2 * sp;
    double cp = 4.7794773323873853e-14; cp = cp * x2 - 1.1470745597729725e-11; cp = cp * x2 + 2.0876756987868099e-09; cp = cp * x2 - 2.7557319223985891e-07;
    cp = cp * x2 + 2.4801587301587302e-05; cp = cp * x2 - 1.3888888888888889e-03; cp = cp * x2 + 4.1666666666666667e-02; cp = cp * x2 - 0.5; cp = 1.0 + x2 * cp;
    const int q = ((int)k) & 3;
    s = (q == 0) ? sp : (q == 1) ? cp : (q == 2) ? -sp : -cp;
    c = (q == 0) ? cp : (q == 1) ? -sp : (q == 2) ? -cp : sp;
}
__device__ __forceinline__ void sincos_frac(int j, int N, float& s, float& c) { double ds, dc; sincos_d(6.283185307179586476925 * (double)(j & (N - 1)) / (double)N, ds, dc); s = (float)ds; c = (float)dc; }

#define XB_TMO      128
#define XB_XCNT(j)  (256  + 64 * (j))
#define XB_XSUB(j)  (1280 + 64 * (j))
#define XB_XGEN(j)  (2304 + 64 * (j))
#define XB_TOP      3328
#define XB_TOPGEN   3392
#define XCD_BAR_WORDS 3456
#define XB_SPIN_CAP (1u << 18)
__device__ __forceinline__ unsigned xb_ld(unsigned* p)              { return __hip_atomic_load(p, __ATOMIC_RELAXED, __HIP_MEMORY_SCOPE_AGENT); }
__device__ __forceinline__ unsigned xb_add(unsigned* p, unsigned v) { return __hip_atomic_fetch_add(p, v, __ATOMIC_RELAXED, __HIP_MEMORY_SCOPE_AGENT); }
__device__ __forceinline__ unsigned xb_xcc_id() { return (unsigned)__builtin_amdgcn_s_getreg((3 << 11) | 20) & 0xFu; }
#define XB_SPIN(cond, bar) do { unsigned _sp = 0; while (cond) { __builtin_amdgcn_s_sleep(1); \
    if ((++_sp & 255u) == 0u) { if (xb_ld(&(bar)[XB_TMO])) break; if (_sp > XB_SPIN_CAP) { atomicAdd(&(bar)[XB_TMO], 1u); break; } } } } while (0)
struct XcdBarrier { unsigned* bar; unsigned x; volatile LAS unsigned* st; };
__device__ __forceinline__ XcdBarrier xcd_barrier_post(unsigned* bar, volatile LAS unsigned* st) {
    XcdBarrier b; b.bar = bar; b.x = xb_xcc_id(); b.st = st;
    if (threadIdx.x == 0) (void)xb_add(&bar[XB_XCNT(b.x)], 1u);
    return b;
}
__device__ __forceinline__ void xcd_barrier_complete(unsigned* bar, unsigned x, unsigned& nloc, unsigned& nx) {
    const unsigned G = gridDim.x * gridDim.y * gridDim.z;
    unsigned sum, cnt, mine, sp = 0u;
    for (;;) {
        sum = 0u; cnt = 0u; mine = 0u;
#pragma unroll
        for (unsigned j = 0; j < 16; ++j) { const unsigned c = xb_ld(&bar[XB_XCNT(j)]); sum += c; cnt += (c > 0u) ? 1u : 0u; mine = (j == x) ? c : mine; }
        if (sum == G) break;
        __builtin_amdgcn_s_sleep(1);
        if ((++sp & 255u) == 0u) { if (xb_ld(&bar[XB_TMO])) break; if (sp > XB_SPIN_CAP) { atomicAdd(&bar[XB_TMO], 1u); break; } }
    }
    nloc = mine > 0u ? mine : 1u; nx = cnt > 0u ? cnt : 1u;
}
__device__ __forceinline__ void xcd_barrier(const XcdBarrier& b) {
    asm volatile("s_waitcnt vmcnt(0)" ::: "memory");
    __syncthreads();
    if (threadIdx.x == 0) {
        unsigned* bar = b.bar;
        __builtin_amdgcn_s_waitcnt(0);
        unsigned nloc = b.st[0], nx = b.st[1];
        if (nloc == 0u) { xcd_barrier_complete(bar, b.x, nloc, nx); b.st[0] = nloc; b.st[1] = nx; }
        const unsigned old = xb_add(&bar[XB_XSUB(b.x)], 1u);
        const unsigned gen = old / nloc;
        if (old + 1u == (gen + 1u) * nloc) {
            const unsigned og = xb_add(&bar[XB_TOP], 1u);
            const unsigned tg = og / nx;
            if (og + 1u == (tg + 1u) * nx) xb_add(&bar[XB_TOPGEN], 1u);
            else XB_SPIN(xb_ld(&bar[XB_TOPGEN]) == tg, bar);
            xb_add(&bar[XB_XGEN(b.x)], 1u);
            __builtin_amdgcn_fence(__ATOMIC_ACQUIRE, "agent");
            asm volatile("s_waitcnt vmcnt(0)" ::: "memory");
        } else {
            XB_SPIN(xb_ld(&bar[XB_XGEN(b.x)]) == gen, bar);
            __builtin_amdgcn_fence(__ATOMIC_ACQUIRE, "agent");
            asm volatile("s_waitcnt vmcnt(0)" ::: "memory");
        }
    }
    __syncthreads();
}

constexpr int HTB = 128 * 64 * 2;
__device__ __forceinline__ int lds_byte(int r, int c) { const int st = (r >> 4) * 2 + (c >> 5), rr = r & 15, cc = c & 31, ob = rr * 64 + cc * 2; return st * 1024 + (ob ^ (((ob >> 9) & 1) << 5)); }
__device__ __forceinline__ void stage_rc(int b, int& R, int& C) { const int st = b / 1024, sb = b % 1024, swz = sb ^ (((sb >> 9) & 1) << 5); R = (st >> 1) * 16 + swz / 64; C = (st & 1) * 32 + (swz % 64) / 2; }
__device__ __forceinline__ int perm32(int rho) { const int n = rho >> 4, i = rho & 15; return 8 * (i >> 2) + 4 * n + (i & 3); }
struct Unit { const char* A; const char* B; int pm, pn, sub; };
__device__ __forceinline__ void tile_of(int j, int nM, int nN, int& pm, int& pn) {
    const int nwg = nM * nN; int wgid = j;
    { const int q = nwg / 8, r = nwg % 8, xcd = wgid % 8, off = wgid / 8; wgid = (xcd < r ? xcd * (q + 1) : r * (q + 1) + (xcd - r) * q) + off; }
    const int nig = 8 * nN, gid = wgid / nig, fm = gid * 8, gsz = (nM - fm) < 8 ? (nM - fm) : 8;
    pm = fm + ((wgid % nig) % gsz); pn = (wgid % nig) / gsz;
}
template <class G>
__device__ __forceinline__ void unit_ready(const G& g, const Unit& u, int wid) {
    if constexpr (G::WAITS) {
        if (wid == 0) { unsigned need; const unsigned* c = g.wait_ctr(u, need); unsigned spins = 0;
            while ((unsigned)__builtin_amdgcn_readfirstlane(__hip_atomic_load(c, __ATOMIC_RELAXED, __HIP_MEMORY_SCOPE_AGENT)) < need) { __builtin_amdgcn_s_sleep(2); if (++spins > (1u << 22)) break; }
            if constexpr (G::WAIT2X) { unsigned need2; const unsigned* c2 = g.wait_ctr2(u, need2); spins = 0;
                while ((unsigned)__builtin_amdgcn_readfirstlane(__hip_atomic_load(c2, __ATOMIC_RELAXED, __HIP_MEMORY_SCOPE_AGENT)) < need2) { __builtin_amdgcn_s_sleep(2); if (++spins > (1u << 22)) break; } }
            __builtin_amdgcn_fence(__ATOMIC_ACQUIRE, "agent"); asm volatile("s_waitcnt vmcnt(0)" ::: "memory"); }
        asm volatile("" ::: "memory"); __builtin_amdgcn_s_barrier(); asm volatile("" ::: "memory");
    }
}
template <class G>
__device__ __forceinline__ void unit_done(const G& g, const Unit& u, int lane) {
    if constexpr (G::SIGNALS) { asm volatile("s_waitcnt vmcnt(0)" ::: "memory"); if (lane == 0) __hip_atomic_fetch_add(g.done_ctr(u), 1u, __ATOMIC_RELAXED, __HIP_MEMORY_SCOPE_AGENT); }
}
template <class G>
__device__ __forceinline__ void gemm_phase(LAS unsigned char* lds, const G& g, const int L0, const int count) {
    constexpr int K = G::K, nt = K / 64;
    static_assert(nt % 2 == 0 && nt >= 2, "K");
    int tid = threadIdx.x; asm volatile("" : "+v"(tid));
    const int wid = __builtin_amdgcn_readfirstlane(tid >> 6), lane = tid & 63, wr = wid >> 2, wc = wid & 3, fr = lane & 15, fq = lane >> 4;
    const int Gn = gridDim.x;
    int j = ((int)blockIdx.x - L0) % Gn; if (j < 0) j += Gn;
    if (j >= count) return;
    unsigned voffA[2], voffB[2];
#pragma unroll
    for (int i = 0; i < 2; ++i) { int R, C; stage_rc(tid * 16 + i * 8192, R, C); const int Rb = G::PERM ? (R & ~31) + perm32(R & 31) : R;
        voffA[i] = g.offA(R) + (unsigned)C * 2u; voffB[i] = g.offB(Rb) + (unsigned)C * 2u; }
    const size_t kstep = 128, hsA = G::HSA, hsB = G::HSB;
    const unsigned ldsw = (unsigned)wid * 1024u;
    const int aoff = lds_byte(wr * (16 * G::MH) + fr, fq * 8), boff = lds_byte(wc * 32 + fr, fq * 8);
#define PG8_SA(b, h) (((b) * 2 + (h)) * HTB)
#define PG8_SB(b, h) ((4 + (b) * 2 + (h)) * HTB)
#define PG8_STAGE(bufoff, gbase, voff) do { _Pragma("unroll") for (int _i = 0; _i < 2; ++_i) \
        __builtin_amdgcn_global_load_lds((const unsigned*)((const char*)(gbase) + (voff)[_i]), (LAS unsigned*)(lds + (bufoff) + ldsw + _i * 8192), 16, 0, 0); } while (0)
#define PG8_CAT(x, y) __builtin_bit_cast(v8i, __builtin_shufflevector(x, y, 0, 1, 2, 3, 4, 5, 6, 7, 8, 9, 10, 11, 12, 13, 14, 15))
#define PG8_LDA(dst, b, h) do { _Pragma("unroll") for (int m = 0; m < G::MH; ++m) { \
        if constexpr (G::FP8) dst##8[m] = PG8_CAT(*(const LAS bf16x8*)(lds + PG8_SA(b, h) + aoff + m * 2048), *(const LAS bf16x8*)(lds + PG8_SA(b, h) + aoff + m * 2048 + 1024)); \
        else { _Pragma("unroll") for (int k = 0; k < 2; ++k) dst[m][k] = *(const LAS bf16x8*)(lds + PG8_SA(b, h) + aoff + m * 2048 + k * 1024); } } } while (0)
#define PG8_LDB(dst, b, h) do { _Pragma("unroll") for (int n = 0; n < 2; ++n) { \
        if constexpr (G::FP8) dst##8[n] = PG8_CAT(*(const LAS bf16x8*)(lds + PG8_SB(b, h) + boff + n * 2048), *(const LAS bf16x8*)(lds + PG8_SB(b, h) + boff + n * 2048 + 1024)); \
        else { _Pragma("unroll") for (int k = 0; k < 2; ++k) dst[n][k] = *(const LAS bf16x8*)(lds + PG8_SB(b, h) + boff + n * 2048 + k * 1024); } } } while (0)
#define PG8_MMA(ai, bj, At, Bt) do { __builtin_amdgcn_s_setprio(1); _Pragma("unroll") for (int m = 0; m < G::MH; ++m) _Pragma("unroll") for (int n = 0; n < 2; ++n) { \
        if constexpr (G::FP8) asm volatile("v_mfma_f32_16x16x128_f8f6f4 %0, %1, %2, %0" : "+v"(acc[ai][bj][m][n]) : "v"(Bt##8[n]), "v"(At##8[m])); \
        else { _Pragma("unroll") for (int k = 0; k < 2; ++k) acc[ai][bj][m][n] = __builtin_amdgcn_mfma_f32_16x16x32_bf16(Bt[n][k], At[m][k], acc[ai][bj][m][n], 0, 0, 0); } } \
        __builtin_amdgcn_s_setprio(0); } while (0)
#ifdef SAFE_ENGINE
#define PG8_WAIT_V(n) asm volatile("s_waitcnt vmcnt(0)" ::: "memory")
#else
#define PG8_WAIT_V(n) asm volatile("s_waitcnt vmcnt(" #n ")" ::: "memory")
#endif
#define PG8_WAIT_L(n) asm volatile("s_waitcnt lgkmcnt(" #n ")" ::: "memory")
#define PG8_BAR __builtin_amdgcn_s_barrier()
#define PG8_SCHED __builtin_amdgcn_sched_barrier(0)
    Unit cur, nxt;
    int sub = 0;
    if constexpr (G::SUBS == 1) { g.unit(j, cur); cur.sub = 0; } else g.unit(j, 0, cur);
    asm volatile("" : "+s"(cur.A), "+s"(cur.B));
    f32x4 acc[2][2][4][2];
#pragma unroll
    for (int a = 0; a < 2; ++a)
#pragma unroll
        for (int b = 0; b < 2; ++b)
#pragma unroll
            for (int m = 0; m < 4; ++m)
#pragma unroll
                for (int n = 0; n < 2; ++n) acc[a][b][m][n] = (f32x4){0.f, 0.f, 0.f, 0.f};
    bf16x8 At[4][2], B0[2][2], B1[2][2];
    v8i At8[4], B08[2], B18[2];
    const char* cA = cur.A; const char* cB = cur.B;
    unit_ready(g, cur, wid);
    PG8_STAGE(PG8_SB(0, 0), cB, voffB); PG8_STAGE(PG8_SB(0, 1), cB + hsB, voffB); PG8_STAGE(PG8_SA(0, 0), cA, voffA); PG8_STAGE(PG8_SA(0, 1), cA + hsA, voffA);
    if (wr == 1) PG8_BAR;
    PG8_WAIT_V(2); PG8_BAR;
    PG8_STAGE(PG8_SB(1, 0), cB + kstep, voffB); PG8_STAGE(PG8_SA(1, 0), cA + kstep, voffA); PG8_STAGE(PG8_SB(1, 1), cB + hsB + kstep, voffB);
    PG8_WAIT_V(6); PG8_BAR;
    for (;;) {
        const bool more_subs = (G::SUBS > 1) && (sub + 1 < G::SUBS);
        const bool has_next = more_subs || (j + Gn < count);
        if (has_next) { if constexpr (G::SUBS == 1) { g.unit(j + Gn, nxt); nxt.sub = 0; } else { if (more_subs) g.unit(j, sub + 1, nxt); else g.unit(j + Gn, 0, nxt); }
            asm volatile("" : "+s"(nxt.A), "+s"(nxt.B)); }
        const char* nA = has_next ? nxt.A : cA; const char* nB = has_next ? nxt.B : cB;
#pragma unroll 1
        for (int t = 0; t < nt; t += 2) {
            const bool last = (t == nt - 2);
            const char* a1 = cA + (size_t)(t + 1) * kstep;
            const char* a2 = last ? nA : cA + (size_t)(t + 2) * kstep; const char* b2 = last ? nB : cB + (size_t)(t + 2) * kstep;
            const char* a3 = a2 + kstep; const char* b3 = b2 + kstep;
            if (last && has_next) unit_ready(g, nxt, wid);
            PG8_LDB(B0, 0, 0); PG8_LDB(B1, 0, 1); PG8_SCHED; PG8_LDA(At, 0, 0); PG8_STAGE(PG8_SA(1, 1), a1 + hsA, voffA);
            PG8_WAIT_V(8); PG8_WAIT_L(0); PG8_BAR; PG8_MMA(0, 0, At, B0); PG8_MMA(0, 1, At, B1); PG8_BAR; PG8_SCHED;
            PG8_LDA(At, 0, 1); PG8_STAGE(PG8_SB(0, 0), b2, voffB); PG8_STAGE(PG8_SB(0, 1), b2 + hsB, voffB); PG8_STAGE(PG8_SA(0, 0), a2, voffA);
            PG8_WAIT_V(8); PG8_WAIT_L(0); PG8_BAR; PG8_MMA(1, 0, At, B0); PG8_MMA(1, 1, At, B1); PG8_BAR; PG8_SCHED;
            PG8_LDB(B0, 1, 0); PG8_LDB(B1, 1, 1); PG8_SCHED; PG8_LDA(At, 1, 0); PG8_STAGE(PG8_SA(0, 1), a2 + hsA, voffA);
            PG8_WAIT_V(8); PG8_WAIT_L(0); PG8_BAR; PG8_MMA(0, 0, At, B0); PG8_MMA(0, 1, At, B1); PG8_BAR; PG8_SCHED;
            PG8_LDA(At, 1, 1); PG8_STAGE(PG8_SB(1, 0), b3, voffB); PG8_STAGE(PG8_SB(1, 1), b3 + hsB, voffB); PG8_STAGE(PG8_SA(1, 0), a3, voffA);
            PG8_WAIT_V(8); PG8_WAIT_L(0); PG8_BAR; PG8_MMA(1, 0, At, B0); PG8_MMA(1, 1, At, B1); PG8_BAR; PG8_SCHED;
        }
        if (wr == 0) PG8_BAR;
        if constexpr (G::FP8) asm volatile("s_nop 15\n\ts_nop 15" ::: "memory");
        g.epi(acc, cur, wr, wc, fr, fq);
        if (!more_subs) unit_done(g, cur, lane);
        if (!has_next) break;
        if (!more_subs) {
#pragma unroll
        for (int a = 0; a < 2; ++a)
#pragma unroll
            for (int b = 0; b < 2; ++b)
#pragma unroll
                for (int m = 0; m < 4; ++m)
#pragma unroll
                    for (int n = 0; n < 2; ++n) acc[a][b][m][n] = (f32x4){0.f, 0.f, 0.f, 0.f};
        }
        cur = nxt; cA = nA; cB = nB; if (more_subs) ++sub; else { sub = 0; j += Gn; }
        if (wr == 1) PG8_BAR;
    }
    PG8_WAIT_V(0);
    PG8_BAR;
#undef PG8_SA
#undef PG8_SB
#undef PG8_STAGE
#undef PG8_LDA
#undef PG8_LDB
#undef PG8_MMA
#undef PG8_CAT
#undef PG8_WAIT_V
#undef PG8_WAIT_L
#undef PG8_BAR
#undef PG8_SCHED
}

__device__ __forceinline__ int mod_of(size_t t) { return t < 4096 ? 0 : (t < 8192 ? 1 : 2); }
#define EPI_ARGS f32x4 (&acc)[2][2][4][2], const Unit& u, int wr, int wc, int fr, int fq
struct G1a {
    static constexpr bool PERM = true, WAITS = false, SIGNALS = false; static constexpr bool FP8 = false; static constexpr bool WAIT2X = false; static constexpr int MH = 4, SUBS = 1, K = 1024; static constexpr size_t HSA = 128 * 2048, HSB = 128 * 2048;
    const char* HB; const char* W; bf16_t* UH; bf16_t* SG;
    __device__ __forceinline__ unsigned offA(int R) const { return (unsigned)R * 2048u; }
    __device__ __forceinline__ unsigned offB(int R) const { return (unsigned)R * 2048u; }
    __device__ __forceinline__ void unit(int j, Unit& u) const { tile_of(j, 48, 10, u.pm, u.pn); u.A = HB + (size_t)u.pm * 256 * 2048; u.B = W + (size_t)u.pn * 256 * 2048; }
    __device__ __forceinline__ void epi(EPI_ARGS) const {
#pragma unroll
        for (int ai = 0; ai < 2; ++ai)
#pragma unroll
            for (int m = 0; m < 4; ++m) { const int t = u.pm * 256 + 128 * ai + 64 * wr + 16 * m + fr;
#pragma unroll
                for (int bj = 0; bj < 2; ++bj) { const int col = u.pn * 256 + 128 * bj + 32 * wc + 8 * fq; const f32x4 a = acc[ai][bj][m][0], b = acc[ai][bj][m][1];
                    if (u.pn < 2) { const int gg = col >> 4, h0 = col & 15; st16(UH + ((size_t)(gg * NCH + (t >> 4)) * 512 + (t & 15) * 16 + h0), pack8(a, b)); }
                    else { f32x4 sa, sb;
#pragma unroll
                        for (int q = 0; q < 4; ++q) { sa[q] = sigm(a[q]); sb[q] = sigm(b[q]); }
                        st16(SG + ((size_t)t * 2048 + (col - 512)), pack8(sa, sb)); } } }
    }
};
struct G1b {
    static constexpr bool PERM = true, WAITS = false, SIGNALS = false; static constexpr bool FP8 = false; static constexpr bool WAIT2X = false; static constexpr int MH = 4, SUBS = 1, K = 1024; static constexpr size_t HSA = 128 * 2048, HSB = 2 * 2048;
    const char* HB; const char* W; bf16_t* XS;
    __device__ __forceinline__ unsigned offA(int R) const { return (unsigned)R * 2048u; }
    __device__ __forceinline__ unsigned offB(int R) const { return (unsigned)(64 * (R & 63) + (R >> 6)) * 2048u; }
    __device__ __forceinline__ void unit(int j, Unit& u) const { tile_of(j, 4, 32, u.pm, u.pn); u.A = W + (size_t)u.pm * 256 * 2048; const int s = u.pn >> 4, a0 = 4 * (u.pn & 15); u.B = HB + (size_t)(NTP + 4096 * s + a0) * 2048; }
    __device__ __forceinline__ void epi(EPI_ARGS) const {
        const int s = u.pn >> 4, a0 = 4 * (u.pn & 15);
#pragma unroll
        for (int ai = 0; ai < 2; ++ai)
#pragma unroll
            for (int m = 0; m < 4; ++m) { const int q = 64 * wr + 16 * m + fr, gq = u.pm * 128 + q;
#pragma unroll
                for (int bj = 0; bj < 2; ++bj) { const int la = a0 + 2 * bj + (wc >> 1), lb0 = 32 * (wc & 1) + 8 * fq;
                    const size_t idx = ((((size_t)((gq >> 1) * 2 + s) * 64 + la) * 2 + (gq & 1)) * 2 + ai) * 64 + lb0;
                    st16(XS + idx, pack8(acc[ai][bj][m][0], acc[ai][bj][m][1])); } }
    }
};
struct G1c {
    static constexpr bool PERM = true, WAITS = false, SIGNALS = false; static constexpr bool FP8 = false; static constexpr bool WAIT2X = false; static constexpr int MH = 4, SUBS = 1, K = 1024; static constexpr size_t HSA = 128 * 2048, HSB = 128 * 2048;
    const char* HB; const char* W; bf16_t* XP;
    __device__ __forceinline__ unsigned offA(int R) const { return (unsigned)R * 2048u; }
    __device__ __forceinline__ unsigned offB(int R) const { return (unsigned)R * 2048u; }
    __device__ __forceinline__ void unit(int j, Unit& u) const { tile_of(j, 4, 16, u.pm, u.pn); u.A = W + (size_t)u.pm * 256 * 2048; u.B = HB + (size_t)(256 * u.pn) * 2048; }
    __device__ __forceinline__ void epi(EPI_ARGS) const {
#pragma unroll
        for (int ai = 0; ai < 2; ++ai)
#pragma unroll
            for (int m = 0; m < 4; ++m) { const int q = 64 * wr + 16 * m + fr, gq = u.pm * 128 + q;
#pragma unroll
                for (int bj = 0; bj < 2; ++bj) { const int l0 = 128 * bj + 32 * wc + 8 * fq;
                    const size_t idx = ((size_t)(u.pn * 512 + gq) * 2 + ai) * 256 + l0;
                    st16(XP + idx, pack8(acc[ai][bj][m][0], acc[ai][bj][m][1])); } }
    }
};
struct Gglu {
    static constexpr bool PERM = true, WAITS = false, SIGNALS = true; static constexpr bool FP8 = false; static constexpr bool WAIT2X = false; static constexpr int MH = 3, SUBS = 1, K = 512; static constexpr size_t HSA = 96 * 1024, HSB = 128 * 1024;
    const char* ZB; const char* W; const float* bias; bf16_t* YS;
    unsigned* CNT;
    __device__ __forceinline__ unsigned* done_ctr(const Unit& u) const { return CNT + (0 * 48 + u.pm) * 16; }
    __device__ __forceinline__ unsigned offA(int R) const { return (unsigned)R * 1024u; }
    __device__ __forceinline__ unsigned offB(int R) const { return (unsigned)R * 1024u; }
    __device__ __forceinline__ void unit(int j, Unit& u) const { tile_of(j, 64, 2, u.pm, u.pn); u.A = ZB + (size_t)u.pm * 192 * 1024; u.B = W + (size_t)u.pn * 256 * 1024; }
    __device__ __forceinline__ void epi(EPI_ARGS) const {
#pragma unroll
        for (int bj = 0; bj < 2; ++bj) { const int col = u.pn * 256 + 128 * bj + 32 * wc + 8 * fq;
            const f32x4 b0 = *(const f32x4*)(bias + col), b1 = *(const f32x4*)(bias + col + 4);
#pragma unroll
            for (int ai = 0; ai < 2; ++ai)
#pragma unroll
                for (int m = 0; m < 3; ++m) { const int t = u.pm * 192 + 96 * ai + 48 * wr + 16 * m + fr;
                    f32x4 z0, z1; unpack8(*(const u32x4*)((const bf16_t*)ZB + (size_t)t * 512 + col), z0, z1);
                    f32x4 a = acc[ai][bj][m][0] + b0, b = acc[ai][bj][m][1] + b1;
#pragma unroll
                    for (int q = 0; q < 4; ++q) { a[q] = z0[q] * sigm(a[q]); b[q] = z1[q] * sigm(b[q]); }
                    st16(YS + (size_t)t * 512 + col, pack8(a, b)); asm volatile("" ::: "memory"); } }
    }
};
struct Gps {
    static constexpr bool PERM = true, WAITS = true, SIGNALS = false; static constexpr bool FP8 = false; static constexpr bool WAIT2X = false; static constexpr int MH = 4, SUBS = 1, K = 512; static constexpr size_t HSA = 128 * 1024, HSB = 128 * 1024;
    const char* A; const char* W; const bf16_t* SG; float* T1;
    unsigned* CNT;
    __device__ __forceinline__ const unsigned* wait_ctr(const Unit& u, unsigned& need) const { need = 2 * 8; return CNT + (0 * 48 + u.pm) * 16; }
    __device__ __forceinline__ unsigned offA(int R) const { return (unsigned)R * 1024u; }
    __device__ __forceinline__ unsigned offB(int R) const { return (unsigned)R * 1024u; }
    __device__ __forceinline__ void unit(int j, Unit& u) const { tile_of(j, 48, 4, u.pm, u.pn); u.A = A + (size_t)u.pm * 256 * 1024; u.B = W + (size_t)u.pn * 256 * 1024; }
    __device__ __forceinline__ void epi(EPI_ARGS) const {
#pragma unroll
        for (int ai = 0; ai < 2; ++ai)
#pragma unroll
            for (int m = 0; m < 4; ++m) { const int t = u.pm * 256 + 128 * ai + 64 * wr + 16 * m + fr;
#pragma unroll
                for (int bj = 0; bj < 2; ++bj) { const int col = u.pn * 256 + 128 * bj + 32 * wc + 8 * fq;
                    f32x4 s0, s1; unpack8(*(const u32x4*)(SG + (size_t)t * 2048 + col), s0, s1);
                    *(f32x4*)(T1 + (size_t)t * 1024 + col) = s0 * acc[ai][bj][m][0]; *(f32x4*)(T1 + (size_t)t * 1024 + col + 4) = s1 * acc[ai][bj][m][1];     } asm volatile("" ::: "memory"); }
    }
};
struct Gpf {
    static constexpr bool PERM = true, WAITS = false, SIGNALS = false; static constexpr bool FP8 = false; static constexpr bool WAIT2X = false; static constexpr int MH = 4, SUBS = 1, K = 512; static constexpr size_t HSA = 128 * 1024, HSB = 128 * 1024;
    const char* A; const char* W; const bf16_t* SG; const float* T1; bf16_t* MB;
    __device__ __forceinline__ unsigned offA(int R) const { return (unsigned)R * 1024u; }
    __device__ __forceinline__ unsigned offB(int R) const { return (unsigned)R * 1024u; }
    __device__ __forceinline__ void unit(int j, Unit& u) const { tile_of(j, 48, 4, u.pm, u.pn); u.A = A + (size_t)u.pm * 256 * 1024; u.B = W + (size_t)u.pn * 256 * 1024; }
    __device__ __forceinline__ void epi(EPI_ARGS) const {
#pragma unroll
        for (int ai = 0; ai < 2; ++ai)
#pragma unroll
            for (int m = 0; m < 4; ++m) { const int t = u.pm * 256 + 128 * ai + 64 * wr + 16 * m + fr;
#pragma unroll
                for (int bj = 0; bj < 2; ++bj) { const int col = u.pn * 256 + 128 * bj + 32 * wc + 8 * fq;
                    f32x4 s0, s1; unpack8(*(const u32x4*)(SG + (size_t)t * 2048 + 1024 + col), s0, s1);
                    const f32x4 t0 = *(const f32x4*)(T1 + (size_t)t * 1024 + col), t1 = *(const f32x4*)(T1 + (size_t)t * 1024 + col + 4);
                    st16(MB + (size_t)t * 1024 + col, pack8(t0 + s0 * acc[ai][bj][m][0], t1 + s1 * acc[ai][bj][m][1])); } asm volatile("" ::: "memory"); }
    }
};
struct Gproj {
    static constexpr bool PERM = true, WAITS = true, SIGNALS = false; static constexpr bool FP8 = false; static constexpr bool WAIT2X = false; static constexpr int MH = 3, SUBS = 2, K = 512; static constexpr size_t HSA = 96 * 1024, HSB = 128 * 1024;
    const char* YS; const char* YF; const char* WPS; const char* WPF; const bf16_t* SG; bf16_t* MB; unsigned* CNT;
    __device__ __forceinline__ const unsigned* wait_ctr(const Unit& u, unsigned& need) const { need = u.sub == 0 ? 2 * 8 : 0; return CNT + (0 * 48 + u.pm) * 16; }
    __device__ __forceinline__ unsigned offA(int R) const { return (unsigned)R * 1024u; }
    __device__ __forceinline__ unsigned offB(int R) const { return (unsigned)R * 1024u; }
    __device__ __forceinline__ void unit(int j, int sub, Unit& u) const { tile_of(j, 64, 4, u.pm, u.pn); u.sub = sub; u.A = (sub ? YF : YS) + (size_t)u.pm * 192 * 1024; u.B = (sub ? WPF : WPS) + (size_t)u.pn * 256 * 1024; }
    __device__ __forceinline__ void epi(EPI_ARGS) const {
#pragma unroll
        for (int ai = 0; ai < 2; ++ai)
#pragma unroll
            for (int m = 0; m < 3; ++m) { const int t = u.pm * 192 + 96 * ai + 48 * wr + 16 * m + fr;
#pragma unroll
                for (int bj = 0; bj < 2; ++bj) { const int col = u.pn * 256 + 128 * bj + 32 * wc + 8 * fq;
                    f32x4 f0, f1; unpack8(*(const u32x4*)(SG + (size_t)t * 2048 + 1024 + col), f0, f1);
                    if (u.sub == 0) { f32x4 s0, s1; unpack8(*(const u32x4*)(SG + (size_t)t * 2048 + col), s0, s1);
#pragma unroll
                        for (int q = 0; q < 4; ++q) { acc[ai][bj][m][0][q] *= s0[q] * __builtin_amdgcn_rcpf(f0[q]); acc[ai][bj][m][1][q] *= s1[q] * __builtin_amdgcn_rcpf(f1[q]); } }
                    else st16(MB + (size_t)t * 1024 + col, pack8(acc[ai][bj][m][0] * f0, acc[ai][bj][m][1] * f1)); }
                asm volatile("" ::: "memory"); }
    }
};

struct Gwo {
    static constexpr bool PERM = true, WAITS = false, SIGNALS = false; static constexpr bool FP8 = false; static constexpr bool WAIT2X = false; static constexpr int MH = 3, SUBS = 1, K = 1024; static constexpr size_t HSA = 96 * 2048, HSB = 128 * 2048;
    const char* A; const char* W; const float* xp; const float* xs; const float* MOD; const float* g2; bf16_t* X1; bf16_t* A2B; float* SSQ;
    __device__ __forceinline__ unsigned offA(int R) const { return (unsigned)R * 2048u; }
    __device__ __forceinline__ unsigned offB(int R) const { return (unsigned)R * 2048u; }
    __device__ __forceinline__ void unit(int j, Unit& u) const { tile_of(j, 64, 4, u.pm, u.pn); u.A = A + (size_t)u.pm * 192 * 2048; u.B = W + (size_t)u.pn * 256 * 2048; }
    __device__ __forceinline__ void epi(EPI_ARGS) const {
#pragma unroll
        for (int ai = 0; ai < 2; ++ai)
#pragma unroll
            for (int m = 0; m < 3; ++m) { const size_t t = (size_t)u.pm * 192 + 96 * ai + 48 * wr + 16 * m + fr;
                const float* md = MOD + mod_of(t) * 6144;
                const float* xin = t < 4096 ? xp + t * 1024 : xs + (t - 4096) * 1024;
                float ss = 0.f;
#pragma unroll
                for (int bj = 0; bj < 2; ++bj) { const int col = u.pn * 256 + 128 * bj + 32 * wc + 8 * fq;
                    const f32x4 ga = *(const f32x4*)(md + 2048 + col), gb = *(const f32x4*)(md + 2048 + col + 4);
                    const f32x4 sa = (*(const f32x4*)(md + 4096 + col) + 1.0f) * *(const f32x4*)(g2 + col), sb = (*(const f32x4*)(md + 4096 + col + 4) + 1.0f) * *(const f32x4*)(g2 + col + 4);
                    const f32x4 x0 = *(const f32x4*)(xin + col) + ga * acc[ai][bj][m][0], x1 = *(const f32x4*)(xin + col + 4) + gb * acc[ai][bj][m][1];
                    *(u32x4*)(X1 + t * 1024 + col) = pack8(x0, x1);
                    st16(A2B + t * 1024 + col, pack8(x0 * sa, x1 * sb));
                    ss += (x0[0] * x0[0] + x0[1] * x0[1]) + (x0[2] * x0[2] + x0[3] * x0[3]) + (x1[0] * x1[0] + x1[1] * x1[1]) + (x1[2] * x1[2] + x1[3] * x1[3]); }
                ss += __shfl_xor(ss, 16); ss += __shfl_xor(ss, 32);
                if (fq == 0) st4f(SSQ + t * 16 + u.pn * 4 + wc, ss);
                asm volatile("" ::: "memory"); }
    }
};

struct Ggu {
    static constexpr bool PERM = true, WAITS = false, SIGNALS = true; static constexpr bool FP8 = false; static constexpr bool WAIT2X = false; static constexpr int MH = 3, SUBS = 1, K = 1024; static constexpr size_t HSA = 96 * 2048, HSB = 128 * 2048;
    const char* A; const char* W; const float* SSQ; const float* SV; bf16_t* FF;
    unsigned* CNT;
    __device__ __forceinline__ unsigned* done_ctr(const Unit& u) const { return CNT + (64 + u.pm) * 16; }
    __device__ __forceinline__ unsigned offA(int R) const { return (unsigned)R * 2048u; }
    __device__ __forceinline__ unsigned offB(int R) const { return (unsigned)R * 2048u; }
    __device__ __forceinline__ void unit(int j, Unit& u) const { tile_of(j, 64, 22, u.pm, u.pn); u.A = A + (size_t)u.pm * 192 * 2048; u.B = W + (size_t)u.pn * 256 * 2048; }
    template <bool UNI>
    __device__ __forceinline__ void epi_t(EPI_ARGS) const {
        const int col = u.pn * 128 + 32 * wc + 8 * fq;
        f32x4 g0, g1, u0, u1;
        if (UNI) { const float* sv = SV + mod_of((size_t)u.pm * 192) * 5632 + u.pn * 256 + 32 * wc + 8 * fq;
            g0 = *(const f32x4*)(sv); g1 = *(const f32x4*)(sv + 4); u0 = *(const f32x4*)(sv + 128); u1 = *(const f32x4*)(sv + 132); }
#pragma unroll
        for (int ai = 0; ai < 2; ++ai)
#pragma unroll
            for (int m = 0; m < 3; ++m) { const size_t t = (size_t)u.pm * 192 + 96 * ai + 48 * wr + 16 * m + fr;
                if (!UNI) { const float* sv = SV + mod_of(t) * 5632 + u.pn * 256 + 32 * wc + 8 * fq;
                    g0 = *(const f32x4*)(sv); g1 = *(const f32x4*)(sv + 4); u0 = *(const f32x4*)(sv + 128); u1 = *(const f32x4*)(sv + 132); }
                const f32x4* sp = (const f32x4*)(SSQ + t * 16); const f32x4 q4 = (sp[0] + sp[1]) + (sp[2] + sp[3]);
                const float r = __builtin_amdgcn_rsqf(((q4[0] + q4[1]) + (q4[2] + q4[3])) * (1.0f / 1024.0f) + EPS);
                f32x4 ga = acc[ai][0][m][0] * r + g0, gb = acc[ai][0][m][1] * r + g1; const f32x4 ua = acc[ai][1][m][0] * r + u0, ub = acc[ai][1][m][1] * r + u1;
#pragma unroll
                for (int q = 0; q < 4; ++q) { ga[q] = ga[q] * sigm(ga[q]) * ua[q]; gb[q] = gb[q] * sigm(gb[q]) * ub[q]; }
                st8((unsigned char*)FF + t * DFF + col, pack8_fp8(ga, gb));     asm volatile("" ::: "memory"); }
    }
    __device__ __forceinline__ void epi(EPI_ARGS) const {
        if (mod_of((size_t)u.pm * 192) == mod_of((size_t)u.pm * 192 + 191)) epi_t<true>(acc, u, wr, wc, fr, fq); else epi_t<false>(acc, u, wr, wc, fr, fq);
    }
};

struct Gdn {
    static constexpr bool PERM = true, WAITS = true, SIGNALS = false; static constexpr bool FP8 = true; static constexpr bool WAIT2X = false; static constexpr int MH = 3, SUBS = 1, K = 1408  ; static constexpr size_t HSA = 96 * 2816, HSB = 128 * 2816;
    const char* A; const char* W; const bf16_t* X1; const float* MOD; float* OUT; float* SSQ; const float* fing;
    unsigned* CNT;
    __device__ __forceinline__ const unsigned* wait_ctr(const Unit& u, unsigned& need) const { need = 22 * 8; return CNT + (64 + u.pm) * 16; }
    __device__ __forceinline__ unsigned offA(int R) const { return (unsigned)R * 2816u; }
    __device__ __forceinline__ unsigned offB(int R) const { return (unsigned)R * 2816u; }
    __device__ __forceinline__ void unit(int j, Unit& u) const { tile_of(j, 64, 4, u.pm, u.pn); u.A = A + (size_t)u.pm * 192 * 2816; u.B = W + (size_t)u.pn * 256 * 2816; }
    __device__ __forceinline__ void epi(EPI_ARGS) const {
        int pm_ = u.pm, pn_ = u.pn, fr_ = fr; asm volatile("" : "+s"(pm_), "+s"(pn_), "+v"(fr_));
#pragma unroll
        for (int ai = 0; ai < 2; ++ai)
#pragma unroll
            for (int m = 0; m < 3; ++m) { const size_t t = (size_t)pm_ * 192 + 96 * ai + 48 * wr + 16 * m + fr_;
                const float* md = MOD + mod_of(t) * 6144 + 5 * 1024;
                float ss = 0.f;
#pragma unroll
                for (int bj = 0; bj < 2; ++bj) { const int col = pn_ * 256 + 128 * bj + 32 * wc + 8 * fq;
                    const f32x4 ga = *(const f32x4*)(md + col) * 0.03125f, gb = *(const f32x4*)(md + col + 4) * 0.03125f;
                    f32x4 xa, xb; unpack8(*(const u32x4*)(X1 + t * 1024 + col), xa, xb);
                    const f32x4 x0 = xa + ga * acc[ai][bj][m][0], x1 = xb + gb * acc[ai][bj][m][1];
                    ss += (x0[0] * x0[0] + x0[1] * x0[1]) + (x0[2] * x0[2] + x0[3] * x0[3]) + (x1[0] * x1[0] + x1[1] * x1[1]) + (x1[2] * x1[2] + x1[3] * x1[3]); }
                ss += __shfl_xor(ss, 16); ss += __shfl_xor(ss, 32);
                if (fq == 0) st4f(SSQ + t * 16 + pn_ * 4 + wc, ss);
                asm volatile("" ::: "memory"); }
        asm volatile("s_waitcnt vmcnt(0)" ::: "memory");
        unsigned* pc = CNT + (128 + pm_) * 16;
        if ((fr_ | fq) == 0) __hip_atomic_fetch_add(pc, 1u, __ATOMIC_RELAXED, __HIP_MEMORY_SCOPE_AGENT);
        { unsigned spins = 0;
          while ((unsigned)__builtin_amdgcn_readfirstlane(__hip_atomic_load(pc, __ATOMIC_RELAXED, __HIP_MEMORY_SCOPE_AGENT)) < 32u) { __builtin_amdgcn_s_sleep(2); if (++spins > (1u << 22)) break; } }
        __builtin_amdgcn_fence(__ATOMIC_ACQUIRE, "agent"); asm volatile("s_waitcnt vmcnt(0)" ::: "memory");
        asm volatile("" : "+s"(pm_), "+s"(pn_), "+v"(fr_));
#pragma unroll
        for (int ai = 0; ai < 2; ++ai)
#pragma unroll
            for (int m = 0; m < 3; ++m) { const size_t t = (size_t)pm_ * 192 + 96 * ai + 48 * wr + 16 * m + fr_;
                const float* md2 = MOD + mod_of(t) * 6144 + 5 * 1024;
                const f32x4* sp = (const f32x4*)(SSQ + t * 16); const f32x4 q4 = (sp[0] + sp[1]) + (sp[2] + sp[3]);
                const float r = 1.0f / sqrtf(((q4[0] + q4[1]) + (q4[2] + q4[3])) * (1.0f / 1024.0f) + EPS);
#pragma unroll
                for (int bj = 0; bj < 2; ++bj) { const int col = pn_ * 256 + 128 * bj + 32 * wc + 8 * fq;
                    f32x4 xa, xb; unpack8(*(const u32x4*)(X1 + t * 1024 + col), xa, xb);
                    const f32x4 x0 = xa + *(const f32x4*)(md2 + col) * 0.03125f * acc[ai][bj][m][0], x1 = xb + *(const f32x4*)(md2 + col + 4) * 0.03125f * acc[ai][bj][m][1];
                    *(f32x4*)(OUT + t * 1024 + col) = x0 * r * *(const f32x4*)(fing + col);
                    *(f32x4*)(OUT + t * 1024 + col + 4) = x1 * r * *(const f32x4*)(fing + col + 4); }
                asm volatile("" ::: "memory"); }
    }
};


struct GF2 {
    static constexpr bool PERM = true, WAITS = false, SIGNALS = false; static constexpr bool FP8 = false; static constexpr bool WAIT2X = false; static constexpr int MH = 4, SUBS = 1, K = 256; static constexpr size_t HSA = 128 * 512, HSB = 128 * 512;
    const char* D1; const char* XS; const float* TW; bf16_t* Y1;
    __device__ __forceinline__ unsigned offA(int R) const { return (unsigned)R * 512u; }
    __device__ __forceinline__ unsigned offB(int R) const { return (unsigned)R * 512u; }
    __device__ __forceinline__ void unit(int j, Unit& u) const { u.pm = 0; u.pn = j; u.A = D1; u.B = XS + (size_t)j * 256 * 512; }
    __device__ __forceinline__ void epi(EPI_ARGS) const {
        const float* tw = TW; int fr2 = fr; asm volatile("" : "+s"(tw), "+v"(fr2));
#pragma unroll
        for (int bj = 0; bj < 2; ++bj) { const int combo = 4 * u.pn + 2 * bj + (wc >> 1), s = combo & 1, gq = 2 * (combo >> 1) + wr, la0 = 32 * (wc & 1) + 8 * fq;
#pragma unroll
            for (int m = 0; m < 4; ++m) { const int kb = 16 * m + fr2;
                const f32x4* tp = (const f32x4*)(tw + (size_t)(kb * 64 + la0) * 2);
                const f32x4 t0 = tp[0], t1 = tp[1], t2 = tp[2], t3 = tp[3];
                const f32x4 r0 = acc[0][bj][m][0], r1 = acc[0][bj][m][1], i0 = acc[1][bj][m][0], i1 = acc[1][bj][m][1];
                f32x4 pr0, pr1, pi0, pi1;
                pr0[0] = r0[0] * t0[0] + i0[0] * t0[1]; pi0[0] = i0[0] * t0[0] - r0[0] * t0[1];
                pr0[1] = r0[1] * t0[2] + i0[1] * t0[3]; pi0[1] = i0[1] * t0[2] - r0[1] * t0[3];
                pr0[2] = r0[2] * t1[0] + i0[2] * t1[1]; pi0[2] = i0[2] * t1[0] - r0[2] * t1[1];
                pr0[3] = r0[3] * t1[2] + i0[3] * t1[3]; pi0[3] = i0[3] * t1[2] - r0[3] * t1[3];
                pr1[0] = r1[0] * t2[0] + i1[0] * t2[1]; pi1[0] = i1[0] * t2[0] - r1[0] * t2[1];
                pr1[1] = r1[1] * t2[2] + i1[1] * t2[3]; pi1[1] = i1[1] * t2[2] - r1[1] * t2[3];
                pr1[2] = r1[2] * t3[0] + i1[2] * t3[1]; pi1[2] = i1[2] * t3[0] - r1[2] * t3[1];
                pr1[3] = r1[3] * t3[2] + i1[3] * t3[3]; pi1[3] = i1[3] * t3[2] - r1[3] * t3[3];
                const size_t base = ((((size_t)(s * 512 + gq) * 16 + (kb >> 2)) * 4 + (kb & 3)) * 2) * 64 + la0;
                st16(Y1 + base, pack8(pr0, pr1)); st16(Y1 + base + 64, pack8(pi0, pi1)); asm volatile("" ::: "memory"); } }
    }
};
struct GSA {
    static constexpr bool PERM = false, WAITS = false, SIGNALS = false; static constexpr bool FP8 = false; static constexpr bool WAIT2X = false; static constexpr int MH = 4, SUBS = 1, K = 256; static constexpr size_t HSA = 128 * 1024, HSB = 128 * 512;
    const char* UH; const char* SF; float* SST;
    __device__ __forceinline__ unsigned offA(int R) const { return (unsigned)R * 1024u; }
    __device__ __forceinline__ unsigned offB(int R) const { return (unsigned)R * 512u; }
    __device__ __forceinline__ void unit(int j, Unit& u) const { u.pn = (j * 171) >> 9; u.pm = j - 3 * u.pn; u.A = UH + (size_t)(u.pn * NCH + 256 * u.pm) * 1024; u.B = SF + (size_t)u.pn * 256 * 512; }
    __device__ __forceinline__ void epi(EPI_ARGS) const {
#pragma unroll
        for (int ai = 0; ai < 2; ++ai)
#pragma unroll
            for (int m = 0; m < 4; ++m) { const int chunk = 256 * u.pm + 128 * ai + 64 * wr + 16 * m + fr;
#pragma unroll
                for (int bj = 0; bj < 2; ++bj) { float* d = SST + (size_t)(u.pn * NCH + chunk) * 256 + 128 * bj + 32 * wc + 4 * fq;
                    st16f(d, acc[ai][bj][m][0]); st16f(d + 16, acc[ai][bj][m][1]); } }
    }
};
struct GF3s {
    static constexpr bool PERM = true, WAITS = false, SIGNALS = false; static constexpr bool FP8 = false; static constexpr bool WAIT2X = false; static constexpr int MH = 4, SUBS = 1, K = 512; static constexpr size_t HSA = 128 * 1024, HSB = 8 * 1024;
    const char* D2; const char* Y1; bf16_t* YF;
    __device__ __forceinline__ unsigned offA(int R) const { return (unsigned)R * 1024u; }
    __device__ __forceinline__ unsigned offB(int R) const { return (unsigned)((R & 15) * 16 + (R >> 4)) * 1024u; }
    __device__ __forceinline__ void unit(int j, Unit& u) const { u.pm = j >> 5; u.pn = 16 * (j & 31); u.A = D2; u.B = Y1 + (size_t)((u.pm * 512 + u.pn) * 16) * 1024; }
    __device__ __forceinline__ void epi(EPI_ARGS) const {
#pragma unroll
        for (int ai = 0; ai < 2; ++ai)
#pragma unroll
            for (int m = 0; m < 4; ++m) { const int mu2 = 2 * ai + wr, ka = 16 * m + fr;
#pragma unroll
                for (int bj = 0; bj < 2; ++bj) { const int c0 = 128 * bj + 32 * wc + 8 * fq, kap = c0 >> 4, qi0 = c0 & 15;
                    const int k = 64 * ka + 4 * kap + mu2;
                    st16(YF + (size_t)(NTP + 4096 * u.pm + k) * 512 + u.pn + qi0, pack8(acc[ai][bj][m][0], acc[ai][bj][m][1])); } }
    }
};
struct GF3p {
    static constexpr bool PERM = true, WAITS = false, SIGNALS = false; static constexpr bool FP8 = false; static constexpr bool WAIT2X = false; static constexpr int MH = 4, SUBS = 1, K = 512; static constexpr size_t HSA = 128 * 1024, HSB = 128 * 1024;
    const char* DP; const char* XP; bf16_t* YF;
    __device__ __forceinline__ unsigned offA(int R) const { return (unsigned)R * 1024u; }
    __device__ __forceinline__ unsigned offB(int R) const { return (unsigned)R * 1024u; }
    __device__ __forceinline__ void unit(int j, Unit& u) const { u.pm = 0; u.pn = j; u.A = DP; u.B = XP + (size_t)j * 256 * 1024; }
    __device__ __forceinline__ void epi(EPI_ARGS) const {
#pragma unroll
        for (int ai = 0; ai < 2; ++ai)
#pragma unroll
            for (int m = 0; m < 4; ++m) { const int k = 128 * ai + 64 * wr + 16 * m + fr;
#pragma unroll
                for (int bj = 0; bj < 2; ++bj) { const int xr = 256 * u.pn + 128 * bj + 32 * wc + 8 * fq, b = xr >> 9, gq = xr & 511;
                    st16(YF + (size_t)(256 * b + k) * 512 + gq, pack8(acc[ai][bj][m][0], acc[ai][bj][m][1])); } }
    }
};
struct GSC {
    static constexpr bool PERM = true, WAITS = false, SIGNALS = false; static constexpr bool FP8 = false; static constexpr bool WAIT2X = false; static constexpr int MH = 4, SUBS = 1, K = 512; static constexpr size_t HSA = 128 * 1024, HSB = 128 * 1024;
    const char* UH; const char* ME; bf16_t* ZB;
    __device__ __forceinline__ unsigned offA(int R) const { return (unsigned)R * 1024u; }
    __device__ __forceinline__ unsigned offB(int R) const { return (unsigned)R * 1024u; }
    __device__ __forceinline__ void unit(int j, Unit& u) const { u.pn = (j * 171) >> 9; u.pm = j - 3 * u.pn; u.A = UH + (size_t)(u.pn * NCH + 256 * u.pm) * 1024; u.B = ME + (size_t)u.pn * 256 * 1024; }
    __device__ __forceinline__ void epi(EPI_ARGS) const {
#pragma unroll
        for (int ai = 0; ai < 2; ++ai)
#pragma unroll
            for (int m = 0; m < 4; ++m) { const int chunk = 256 * u.pm + 128 * ai + 64 * wr + 16 * m + fr;
#pragma unroll
                for (int bj = 0; bj < 2; ++bj) { const int c0 = 128 * bj + 32 * wc + 8 * fq, i = c0 >> 4, h0 = c0 & 15;
                    f32x4 a = acc[ai][bj][m][0], b = acc[ai][bj][m][1];
#pragma unroll
                    for (int q = 0; q < 4; ++q) { a[q] = gelu_tanh(a[q]); b[q] = gelu_tanh(b[q]); }
                    st16(ZB + (size_t)(16 * chunk + i) * 512 + 16 * u.pn + h0, pack8(a, b)); } }
    }
};

struct Params {
    const float* in[27];
    float* out;
    unsigned char* wsp;
    int never; int pad;
};

__device__ __forceinline__ void transpose_item(const float* W, int ldw, int n0, int k0, bf16_t* WT, int drow, int Kd, LAS float* scr, int lane) {
    float tv[32];
#pragma unroll
    for (int i = 0; i < 32; ++i) tv[i] = W[(size_t)(k0 + 2 * i + (lane >> 5)) * ldw + n0 + (lane & 31)];
#pragma unroll
    for (int i = 0; i < 32; ++i) scr[(2 * i + (lane >> 5)) * 33 + (lane & 31)] = tv[i];
    asm volatile("s_waitcnt lgkmcnt(0)" ::: "memory");
    const int c = lane & 7;
#pragma unroll
    for (int jj = 0; jj < 4; ++jj) { const int n = (lane >> 3) + 8 * jj; const LAS float* s = scr + (8 * c) * 33 + n;
        u32x4 o; o.x = cvt_pk_bf16(s[0 * 33], s[1 * 33]); o.y = cvt_pk_bf16(s[2 * 33], s[3 * 33]); o.z = cvt_pk_bf16(s[4 * 33], s[5 * 33]); o.w = cvt_pk_bf16(s[6 * 33], s[7 * 33]);
        st16(WT + (size_t)(drow + n) * Kd + k0 + 8 * c, o); }
    asm volatile("s_waitcnt lgkmcnt(0)" ::: "memory");
}

__device__ __forceinline__ void transpose_item_fp8(const float* W, int ldw, int n0, int k0, unsigned char* WT8, int drow, int Kd, float scale, LAS float* scr, int lane) {
    float tv[32];
#pragma unroll
    for (int i = 0; i < 32; ++i) tv[i] = W[(size_t)(k0 + 2 * i + (lane >> 5)) * ldw + n0 + (lane & 31)];
#pragma unroll
    for (int i = 0; i < 32; ++i) scr[(2 * i + (lane >> 5)) * 33 + (lane & 31)] = tv[i] * scale;
    asm volatile("s_waitcnt lgkmcnt(0)" ::: "memory");
    const int c = lane & 7;
#pragma unroll
    for (int jj = 0; jj < 4; ++jj) { const int n = (lane >> 3) + 8 * jj; const LAS float* s = scr + (8 * c) * 33 + n;
        st8(WT8 + (size_t)(drow + n) * Kd + k0 + 8 * c, pack8_fp8((f32x4){s[0 * 33], s[1 * 33], s[2 * 33], s[3 * 33]}, (f32x4){s[4 * 33], s[5 * 33], s[6 * 33], s[7 * 33]})); }
    asm volatile("s_waitcnt lgkmcnt(0)" ::: "memory");
}

__global__ void __launch_bounds__(512, 2) fwd_kernel(Params P) {
    extern __shared__ __attribute__((aligned(16))) unsigned char lds_raw[];
    LAS unsigned char* lds = (LAS unsigned char*)lds_raw;
    cg::grid_group grid = cg::this_grid();
    if (P.never) grid.sync();
    if (threadIdx.x < 2) ((volatile LAS unsigned*)(lds + 8 * HTB + 16384 - 16))[threadIdx.x] = 0u;
    if (PROBE_MASK != 0 && threadIdx.x == 0) ((volatile LAS unsigned long long*)(lds + 8 * HTB + 16384 - 32))[0] = __builtin_amdgcn_s_memrealtime();
    __syncthreads();
    (void)xcd_barrier_post((unsigned*)(P.wsp + WS_BAR), (volatile LAS unsigned*)(lds + 8 * HTB + 16384 - 16));
#define GRID_SYNC1() do { asm volatile("s_waitcnt vmcnt(0) lgkmcnt(0)" ::: "memory"); XcdBarrier _xb; _xb.bar = (unsigned*)(P.wsp + WS_BAR); _xb.x = xb_xcc_id(); _xb.st = (volatile LAS unsigned*)(lds + 8 * HTB + 16384 - 16); xcd_barrier(_xb); } while (0)
#ifndef REP_SYNC
#define REP_SYNC 1
#endif
#define GRID_SYNC_N(n) do { if ((PROBE_MASK >> (n)) & 1) { if (threadIdx.x == 0) { volatile LAS unsigned long long* tp = (volatile LAS unsigned long long*)(lds + 8 * HTB + 16384 - 32); const unsigned long long t0 = tp[0], t1 = __builtin_amdgcn_s_memrealtime(); \
        while (__builtin_amdgcn_s_memrealtime() < 2 * t1 - t0) __builtin_amdgcn_s_sleep(8); } } \
    GRID_SYNC1(); \
    if (PROBE_MASK != 0) { if (threadIdx.x == 0) { volatile LAS unsigned long long* tp = (volatile LAS unsigned long long*)(lds + 8 * HTB + 16384 - 32); tp[0] = __builtin_amdgcn_s_memrealtime(); } } } while (0)
#define FRESH_IDS int tid = threadIdx.x; asm volatile("" : "+v"(tid)); const int lane = tid & 63, wave = __builtin_amdgcn_readfirstlane(tid >> 6); \
    const int gw = blockIdx.x * 8 + wave, NGW = gridDim.x * 8; (void)lane; (void)gw; (void)NGW;
#define ws (P.wsp)
#define x_prompt (P.in[0])
#define x_sample (P.in[1])
#define state_s5 (P.in[2])
#define cvec (P.in[3])
#define c_ctx (P.in[4])
#define norm1_g (P.in[5])
#define norm2_g (P.in[6])
#define w_ada (P.in[7])
#define b_ada (P.in[8])
#define w_in (P.in[9])
#define lam_re (P.in[10])
#define lam_im (P.in[11])
#define log_step (P.in[12])
#define b_re (P.in[13])
#define b_im (P.in[14])
#define c_re (P.in[15])
#define c_im (P.in[16])
#define s5_d (P.in[17])
#define w_glu (P.in[18])
#define b_glu (P.in[19])
#define w_ps (P.in[20])
#define w_pf (P.in[21])
#define w_o (P.in[22])
#define w_g (P.in[23])
#define w_u (P.in[24])
#define w_d (P.in[25])
#define fin_g (P.in[26])
#define CTL ((unsigned*)(ws + WS_CTL))
#define MOD ((float*)(ws + WS_MOD))
#define SVGU ((float*)(ws + WS_SVGU))
#define MODP ((float*)(ws + WS_MODP))
#define SSQ2 ((float*)(ws + WS_SSQ2))
#define SSQ3 ((float*)(ws + WS_SSQ3))
#define W1T ((bf16_t*)(ws + WS_W1T))
#define WFT ((bf16_t*)(ws + WS_WFT))
#define WGLU ((bf16_t*)(ws + WS_WGLU))
#define WPS ((bf16_t*)(ws + WS_WPS))
#define WPF ((bf16_t*)(ws + WS_WPF))
#define WO ((bf16_t*)(ws + WS_WO))
#define WGU ((bf16_t*)(ws + WS_WGU))
#define WD ((bf16_t*)(ws + WS_WD))
#define SG ((bf16_t*)(ws + WS_R1))
#define X1 ((bf16_t*)(ws + WS_R1))
#define UH ((bf16_t*)(ws + WS_R3))
#define A2B ((bf16_t*)(ws + WS_R3))
#define T1 ((float*)(ws + WS_R3))
#define XS ((bf16_t*)(ws + WS_R4))
#define XP ((bf16_t*)(ws + WS_XP))
#define FF ((bf16_t*)(ws + WS_R4))
#define ZB ((bf16_t*)(ws + WS_R5))
#define YS ((bf16_t*)(ws + WS_YS))
#define YF ((bf16_t*)(ws + WS_YF))
#define HB ((bf16_t*)(ws + WS_R2))
#define YACC ((float*)(ws + WS_R2))
#define MB ((bf16_t*)(ws + WS_R2))
#define SST ((float*)(ws + WS_R2))
#define Y1B ((bf16_t*)(ws + WS_R5))
#define SFM ((bf16_t*)(ws + WS_SF))
#define MEM ((bf16_t*)(ws + WS_ME))
#define KKM ((float*)(ws + WS_KK))
#define A16M ((float*)(ws + WS_A16))
#define D1M ((bf16_t*)(ws + WS_D1))
#define D2M ((bf16_t*)(ws + WS_D2))
#define DPM ((bf16_t*)(ws + WS_DP))
#define TWM ((float*)(ws + WS_TW))
#define OUT (P.out)

    {
    {
        FRESH_IDS
        if (blockIdx.x < 128) {
            LAS float* tile = (LAS float*)lds;
            LAS float* cs = tile + 32 * 132; LAS float* sn = cs + 128;
            const int gg = blockIdx.x >> 5, k0 = 32 * (blockIdx.x & 31);
            for (int idx = tid; idx < 32 * 32; idx += 512) { const int row = idx >> 5, c4 = idx & 31;
                const f32x4 v = *(const f32x4*)(w_in + (size_t)(k0 + row) * 3072 + 512 + 128 * gg + 4 * c4);
                *(LAS f32x4*)(tile + row * 132 + 4 * c4) = v; }
            if (tid < 128) { float s, c; sincos_frac(tid, 128, s, c); cs[tid] = c * 0.08838834764831845f; sn[tid] = s * 0.08838834764831845f; }
            __syncthreads();
            const int n = tid & 255, part = n >> 7, q = n & 127, kh = tid >> 8;
            float a[16];
#pragma unroll
            for (int i = 0; i < 16; ++i) a[i] = 0.f;
            const LAS float* tb = part ? sn : cs;
            for (int c = 0; c < 128; c += 4) {
                const float r0 = tb[(q * c) & 127], r1 = tb[(q * (c + 1)) & 127], r2 = tb[(q * (c + 2)) & 127], r3 = tb[(q * (c + 3)) & 127];
#pragma unroll
                for (int i = 0; i < 16; ++i) { const f32x4 w = *(const LAS f32x4*)(tile + (16 * kh + i) * 132 + c); a[i] += (w[0] * r0 + w[1] * r1) + (w[2] * r2 + w[3] * r3); }
            }
            bf16_t* dst = WFT + (size_t)(gg * 256 + n) * 1024 + k0 + 16 * kh;
            u32x4 o0, o1; o0.x = cvt_pk_bf16(a[0], a[1]); o0.y = cvt_pk_bf16(a[2], a[3]); o0.z = cvt_pk_bf16(a[4], a[5]); o0.w = cvt_pk_bf16(a[6], a[7]);
            o1.x = cvt_pk_bf16(a[8], a[9]); o1.y = cvt_pk_bf16(a[10], a[11]); o1.z = cvt_pk_bf16(a[12], a[13]); o1.w = cvt_pk_bf16(a[14], a[15]);
            st16(dst, o0); st16(dst + 8, o1);
            __syncthreads();
        }
        else if (blockIdx.x < 192) {
            LAS float* Wre = (LAS float*)lds; LAS float* Wim = Wre + 16384;
            LAS float* Cre = Wim + 16384; LAS float* Cim = Cre + 16 * 65;
            const int td = blockIdx.x - 128, gg = td >> 1, d = td & 1;
            {
                const int p = tid & 63, hq = tid >> 6, pi = (d * 32 + gg) * 64 + p;
                const float lr = lam_re[pi], li = lam_im[pi], step = __expf(log_step[d * 32 + gg]);
                double sd, cd; sincos_d((double)(li * step), sd, cd);
                const float mag = __expf(lr * step), are = mag * (float)cd, aim = mag * (float)sd;
                const float nr = are - 1.0f, ni = aim, den = lr * lr + li * li, fr_ = (nr * lr + ni * li) / den, fi_ = (ni * lr - nr * li) / den;
                float wr_[2], wi_[2], cr_[2], ci_[2];
#pragma unroll
                for (int e = 0; e < 2; ++e) { const int h = 2 * hq + e; const float br = b_re[(size_t)pi * 16 + h], bi = b_im[(size_t)pi * 16 + h];
                    wr_[e] = fr_ * br - fi_ * bi; wi_[e] = fr_ * bi + fi_ * br;
                    cr_[e] = c_re[((size_t)(d * 32 + gg) * 16 + h) * 64 + p]; ci_[e] = c_im[((size_t)(d * 32 + gg) * 16 + h) * 64 + p];
                    Cre[h * 65 + p] = cr_[e]; Cim[h * 65 + p] = ci_[e]; }
                float pr = are, pim = aim;
#pragma unroll
                for (int m = 0; m < 16; ++m) {
#pragma unroll
                    for (int e = 0; e < 2; ++e) { const int h = 2 * hq + e; Wre[(m * 64 + p) * 16 + h] = wr_[e]; Wim[(m * 64 + p) * 16 + h] = wi_[e];
                        const float nwr = are * wr_[e] - aim * wi_[e], nwi = are * wi_[e] + aim * wr_[e]; wr_[e] = nwr; wi_[e] = nwi;
                        const float vr = cr_[e] * pr - ci_[e] * pim, vi = cr_[e] * pim + ci_[e] * pr;
                        const int irow = d ? 15 - m : m;
                        float* dst = (float*)(MEM + ((size_t)(gg * 256 + 16 * irow + h) * 512 + 256 + d * 128 + 2 * p));
                        st4f(dst, __uint_as_float(cvt_pk_bf16(vr, -vi))); }
                    if (m == 15 && hq == 0) { float* a16 = A16M + (size_t)((gg * 2 + d) * 64 + p) * 2; st4f(a16, pr); st4f(a16 + 1, pim); }
                    const float npr = pr * are - pim * aim, npi = pr * aim + pim * are; pr = npr; pim = npi;
                }
            }
            __syncthreads();
            {
                const int nl = tid >> 2, p = nl >> 1, ri = nl & 1, qt = tid & 3;
                const LAS float* Wsrc = ri ? Wim : Wre;
#pragma unroll
                for (int e = 0; e < 4; ++e) { const int jj = 4 * qt + e, m = d ? jj : 15 - jj;
                    const LAS f32x4* wp = (const LAS f32x4*)(Wsrc + (m * 64 + p) * 16);
                    bf16_t* dst = SFM + ((size_t)(gg * 256 + d * 128 + nl) * 256 + 16 * jj);
                    st16(dst, pack8(wp[0], wp[1])); st16(dst + 8, pack8(wp[2], wp[3])); }
            }
            {
                const int m = tid >> 5, hp = (tid >> 1) & 15, hh = (tid & 1) * 8;
                f32x4 a0 = {0.f, 0.f, 0.f, 0.f}, a1 = a0;
                for (int p = 0; p < 64; ++p) { const float cr = Cre[hp * 65 + p], ci = Cim[hp * 65 + p];
                    const LAS f32x4* wrp = (const LAS f32x4*)(Wre + (m * 64 + p) * 16 + hh); const LAS f32x4* wip = (const LAS f32x4*)(Wim + (m * 64 + p) * 16 + hh);
                    a0 += wrp[0] * cr - wip[0] * ci; a1 += wrp[1] * cr - wip[1] * ci; }
                float* dst = KKM + ((size_t)((gg * 2 + d) * 16 + m) * 256 + hp * 16 + hh);
                st16f(dst, a0); st16f(dst + 4, a1);
            }
            __syncthreads();
        }
        else {
            const int gt = (blockIdx.x - 192) * 512 + tid, ngt = (gridDim.x - 192) * 512;
            for (int tk = gt; tk < 8192 + 16384 + 16384 + 2048; tk += ngt) {
                float v[8];
                if (tk < 8192) {
                    const int r = tk >> 5, k0 = (tk & 31) * 8, pp = r >> 7, mup = (r >> 6) & 1, kb = r & 63, mu = k0 >> 7, part = (k0 >> 6) & 1, lb0 = k0 & 63;
#pragma unroll
                    for (int e = 0; e < 8; ++e) { float s, c; sincos_frac(kb * (lb0 + e), 64, s, c);
                        const float val = (pp == 0) ? (part == 0 ? c : -s) : (part == 0 ? -s : -c); v[e] = (mu == mup) ? val * 0.125f : 0.f; }
                    st16(D1M + (size_t)r * 256 + k0, pack8((f32x4){v[0], v[1], v[2], v[3]}, (f32x4){v[4], v[5], v[6], v[7]}));
                } else if (tk < 8192 + 16384) {
                    const int t2 = tk - 8192, r = t2 >> 6, k0 = (t2 & 63) * 8, mu2 = r >> 6, ka = r & 63, mu2p = k0 >> 7, part = (k0 >> 6) & 1, la0 = k0 & 63;
#pragma unroll
                    for (int e = 0; e < 8; ++e) { float s, c; sincos_frac(ka * (la0 + e), 64, s, c); v[e] = (mu2 == mu2p) ? (part == 0 ? c : s) * 0.125f : 0.f; }
                    st16(D2M + (size_t)r * 512 + k0, pack8((f32x4){v[0], v[1], v[2], v[3]}, (f32x4){v[4], v[5], v[6], v[7]}));
                } else if (tk < 8192 + 32768) {
                    const int t2 = tk - 8192 - 16384, r = t2 >> 6, k0 = (t2 & 63) * 8, part = k0 >> 8, l0 = k0 & 255;
#pragma unroll
                    for (int e = 0; e < 8; ++e) { float s, c; sincos_frac(r * (l0 + e), 256, s, c); v[e] = (part == 0 ? c : -s) * 0.0625f; }
                    st16(DPM + (size_t)r * 512 + k0, pack8((f32x4){v[0], v[1], v[2], v[3]}, (f32x4){v[4], v[5], v[6], v[7]}));
                } else {
                    const int t2 = tk - 8192 - 32768, kb = t2 >> 5, la0 = (t2 & 31) * 2;
                    float s0, c0, s1, c1; sincos_frac(kb * la0, 4096, s0, c0); sincos_frac(kb * (la0 + 1), 4096, s1, c1);
                    st16f(TWM + (size_t)(kb * 64 + la0) * 2, (f32x4){c0, s0, c1, s1});
                }
            }
        }
        __syncthreads();
        if (blockIdx.x >= 160) {
            LAS float* sl = (LAS float*)lds;
            LAS float* red = sl + 3 * 1024;
            for (int k = tid; k < 1024; k += 512) { const float a = c_ctx[k], b = cvec[k], c = cvec[1024 + k]; sl[k] = a * sigm(a); sl[1024 + k] = b * sigm(b); sl[2048 + k] = c * sigm(c); }
            __syncthreads();
            const int cgp = blockIdx.x - 160, k0 = wave * 128;
            const float* wp = w_ada + (size_t)k0 * 6144 + cgp * 64 + lane;
            float a0 = 0.f, a1 = 0.f, a2 = 0.f;
            for (int kb = 0; kb < 128; kb += 32) {
                float w[32];
#pragma unroll
                for (int e = 0; e < 32; ++e) w[e] = wp[(size_t)(kb + e) * 6144];
#pragma unroll
                for (int e = 0; e < 32; ++e) { const int k = k0 + kb + e; a0 += w[e] * sl[k]; a1 += w[e] * sl[1024 + k]; a2 += w[e] * sl[2048 + k]; }
            }
            red[(wave * 3 + 0) * 64 + lane] = a0; red[(wave * 3 + 1) * 64 + lane] = a1; red[(wave * 3 + 2) * 64 + lane] = a2;
            __syncthreads();
            if (tid < 192) { const int mi = tid >> 6, c = tid & 63; float s = b_ada[cgp * 64 + c];
#pragma unroll
                for (int w8 = 0; w8 < 8; ++w8) s += red[(w8 * 3 + mi) * 64 + c];
                st4f(MOD + mi * 6144 + cgp * 64 + c, s); }
            __syncthreads();
        }
        LAS float* scr = (LAS float*)(lds + 32768 + wave * 8704);
        for (int it = gw; it < 1920; it += NGW) {
            int r = it;
            if (r < 256) { const int kb = r / 16, nb = r % 16; transpose_item(w_in, 3072, 32 * nb, 64 * kb, W1T, 32 * nb, 1024, scr, lane); continue; } r -= 256;
            if (r < 1024) { const int kb = r / 64, nb = r % 64; transpose_item(w_in, 3072, 1024 + 32 * nb, 64 * kb, W1T, 512 + 32 * nb, 1024, scr, lane); continue; } r -= 1024;
            if (r < 128) { const int kb = r / 16, nb = r % 16; transpose_item(w_glu, 512, 32 * nb, 64 * kb, WGLU, 32 * nb, 512, scr, lane); continue; } r -= 128;
            if (r < 256) { const int kb = r / 32, nb = r % 32; transpose_item(w_ps, 1024, 32 * nb, 64 * kb, WPS, 32 * nb, 512, scr, lane); continue; } r -= 256;
            { const int kb = r / 32, nb = r % 32; transpose_item(w_pf, 1024, 32 * nb, 64 * kb, WPF, 32 * nb, 512, scr, lane); }
        }
    }
    GRID_SYNC_N(0);
    {
        FRESH_IDS
        for (int t0 = gw; t0 < NT; t0 += 3 * NGW) {
            f32x4 v[3][4];
#pragma unroll
            for (int rr = 0; rr < 3; ++rr) { const int t = t0 + rr * NGW;
                if (t < NT) { const float* xr = t < NTP ? x_prompt + (size_t)t * 1024 : x_sample + (size_t)(t - NTP) * 1024;
#pragma unroll
                    for (int jx = 0; jx < 4; ++jx) v[rr][jx] = *(const f32x4*)(xr + 8 * lane + 512 * (jx >> 1) + 4 * (jx & 1)); } }
#pragma unroll
            for (int rr = 0; rr < 3; ++rr) { const int t = t0 + rr * NGW;
                if (t < NT) {
                    const int mi = t < NTP ? 0 : (t < NTP + 4096 ? 1 : 2);
                    const float* md = MOD + mi * 6144;
                    float s = 0.f;
#pragma unroll
                    for (int jx = 0; jx < 4; ++jx) s += (v[rr][jx][0] * v[rr][jx][0] + v[rr][jx][1] * v[rr][jx][1]) + (v[rr][jx][2] * v[rr][jx][2] + v[rr][jx][3] * v[rr][jx][3]);
                    const float r = 1.0f / sqrtf(wave_sum(s) * (1.0f / 1024.0f) + EPS);
                    f32x4 h[4];
#pragma unroll
                    for (int jx = 0; jx < 4; ++jx) { const int col = 8 * lane + 512 * (jx >> 1) + 4 * (jx & 1);
                        const f32x4 gs = *(const f32x4*)(norm1_g + col) * (*(const f32x4*)(md + 1024 + col) + 1.0f), sh = *(const f32x4*)(md + col);
                        h[jx] = v[rr][jx] * r * gs + sh; }
                    st16(HB + (size_t)t * 1024 + 8 * lane, pack8(h[0], h[1])); st16(HB + (size_t)t * 1024 + 512 + 8 * lane, pack8(h[2], h[3])); } }
        }
        for (int idx = blockIdx.x * 512 + tid; idx < 131072; idx += gridDim.x * 512) {
            const int gg = idx >> 12, r = (idx >> 4) & 255, jj = idx & 15, i = r >> 4, hp = r & 15;
            f32x4 v0 = {0.f, 0.f, 0.f, 0.f}, v1 = v0, v2 = v0, v3 = v0;
            if (jj <= i) { const f32x4* kp = (const f32x4*)(KKM + ((size_t)((gg * 2 + 0) * 16 + (i - jj)) * 256 + hp * 16)); v0 += kp[0]; v1 += kp[1]; v2 += kp[2]; v3 += kp[3]; }
            if (jj >= i) { const f32x4* kp = (const f32x4*)(KKM + ((size_t)((gg * 2 + 1) * 16 + (jj - i)) * 256 + hp * 16)); v0 += kp[0]; v1 += kp[1]; v2 += kp[2]; v3 += kp[3]; }
            if (jj == i) { const float dv = s5_d[16 * gg + hp];
#pragma unroll
                for (int e = 0; e < 4; ++e) { v0[e] += (hp == e) ? dv : 0.f; v1[e] += (hp == 4 + e) ? dv : 0.f; v2[e] += (hp == 8 + e) ? dv : 0.f; v3[e] += (hp == 12 + e) ? dv : 0.f; } }
            bf16_t* dst = MEM + ((size_t)(gg * 256 + r) * 512 + 16 * jj);
            st16(dst, pack8(v0, v1)); st16(dst + 8, pack8(v2, v3));
        }
    }
    GRID_SYNC_N(1);
    }
#if DBG_STOP == 2
    { FRESH_IDS
      for (size_t i = (size_t)blockIdx.x * 512 + tid; i < (size_t)NT * 1024; i += (size_t)gridDim.x * 512) { const size_t c = i & 1023; OUT[i] = bf2f(HB[i]) + 0.25f * (bf2f(W1T[i % (2560 * 1024)]) + bf2f(WFT[i % (1024 * 1024)]) + bf2f(WGU[i % (5632 * 1024)]) + bf2f(WD[i % (2816 * 1024)])) + MOD[i % 18432]; (void)c; }
      for (size_t i = (size_t)blockIdx.x * 512 + tid; i < 131072; i += (size_t)gridDim.x * 512) { OUT[(size_t)NT * 1024 + i] = SVGU[i % 16896] + bf2f(WGLU[i]) + bf2f(WPS[i]) + bf2f(WPF[i]) + bf2f(WO[i]); }
      return; }
#endif
    {
    { G1a g{(const char*)HB, (const char*)W1T, UH, SG}; gemm_phase(lds, g, 0, 480);
#if REP_P1 > 1
      gemm_phase(lds, g, 0, 480);
#endif
    }
    { G1b g{(const char*)HB, (const char*)WFT, XS}; gemm_phase(lds, g, 480, 128); }
    { G1c g{(const char*)HB, (const char*)WFT, XP}; gemm_phase(lds, g, 608, 64); }
    GRID_SYNC_N(2);
    }
#if DBG_STOP == 1
    { FRESH_IDS
      for (size_t i = (size_t)blockIdx.x * 512 + tid; i < (size_t)NT * 1024; i += (size_t)gridDim.x * 512) { const size_t t = i >> 10, c = i & 1023; OUT[i] = bf2f(SG[t * 2048 + c]) + bf2f(SG[t * 2048 + 1024 + c]); }
      for (size_t i = (size_t)blockIdx.x * 512 + tid; i < 131072; i += (size_t)gridDim.x * 512) { float a = 0.f; for (int r = 0; r < 64; ++r) a += bf2f(XS[i * 64 + r]) + bf2f(XP[i * 32 + (r & 31)]); const size_t u = i * 48; const size_t row = u >> 8, cc = u & 255; a += bf2f(UH[row * 512 + cc]); OUT[(size_t)NT * 1024 + i] = a; }
      return; }
#endif
    {
    { GF2 g{(const char*)D1M, (const char*)XS, TWM, Y1B}; gemm_phase(lds, g, 0, 128); }
    { GSA g{(const char*)UH, (const char*)SFM, SST}; gemm_phase(lds, g, 128, 96); }
    GRID_SYNC_N(3);
    { GF3s g{(const char*)D2M, (const char*)Y1B, YF}; gemm_phase(lds, g, 0, 64); }
    { GF3p g{(const char*)DPM, (const char*)XP, YF}; gemm_phase(lds, g, 64, 32); }
    if (blockIdx.x >= 96) {
        FRESH_IDS
        const int nw = (gridDim.x - 96) * 8;
        for (int tk = (blockIdx.x - 96) * 8 + wave; tk < 1152; tk += nw) {
            int gg, d, nc, cbase, sidx; bool smp;
            if (tk < 128) { smp = true; sidx = tk >> 6; gg = (tk >> 1) & 31; d = tk & 1; nc = 256; cbase = 256 + 256 * sidx; }
            else { const int t2 = tk - 128; smp = false; sidx = t2 >> 6; gg = (t2 >> 1) & 31; d = t2 & 1; nc = 16; cbase = 16 * sidx; }
            const f32x2 a16 = *(const f32x2*)(A16M + (size_t)((gg * 2 + d) * 64 + lane) * 2);
            float hre = 0.f, him = 0.f;
            if (smp) { hre = state_s5[(((size_t)sidx * 2 + d) * 2 + 0) * 2048 + gg * 64 + lane]; him = state_s5[(((size_t)sidx * 2 + d) * 2 + 1) * 2048 + gg * 64 + lane]; }
            const float* sp = SST + (size_t)(gg * NCH + cbase) * 256 + d * 128 + 2 * lane;
            bf16_t* hp = UH + (size_t)(gg * NCH + cbase) * 512 + 256 + d * 128 + 2 * lane;
            const int c0 = d ? nc - 1 : 0, cs = d ? -1 : 1;
            if (nc == 256) {
                f32x2 cur[32], nxt[32];
#pragma unroll
                for (int e = 0; e < 32; ++e) cur[e] = *(const f32x2*)(sp + (ptrdiff_t)(c0 + cs * e) * 256);
                for (int cb = 0; cb < 256; cb += 32) {
                    if (cb + 32 < 256) {
#pragma unroll
                        for (int e = 0; e < 32; ++e) nxt[e] = *(const f32x2*)(sp + (ptrdiff_t)(c0 + cs * (cb + 32 + e)) * 256);
                    }
#pragma unroll
                    for (int e = 0; e < 32; ++e) { const int c = c0 + cs * (cb + e);
                        st4f((float*)(hp + (ptrdiff_t)c * 512), __uint_as_float(cvt_pk_bf16(hre, him)));
                        const float nr = a16[0] * hre - a16[1] * him + cur[e][0], ni = a16[0] * him + a16[1] * hre + cur[e][1]; hre = nr; him = ni; }
#pragma unroll
                    for (int e = 0; e < 32; ++e) cur[e] = nxt[e];
                }
            } else {
                f32x2 cur[16];
#pragma unroll
                for (int e = 0; e < 16; ++e) cur[e] = *(const f32x2*)(sp + (ptrdiff_t)(c0 + cs * e) * 256);
#pragma unroll
                for (int e = 0; e < 16; ++e) { const int c = c0 + cs * e;
                    st4f((float*)(hp + (ptrdiff_t)c * 512), __uint_as_float(cvt_pk_bf16(hre, him)));
                    const float nr = a16[0] * hre - a16[1] * him + cur[e][0], ni = a16[0] * him + a16[1] * hre + cur[e][1]; hre = nr; him = ni; }
            }
            if (!smp) { float* ns = OUT + (size_t)NT * 1024 + (((size_t)sidx * 2 + d) * 2) * 2048 + gg * 64 + lane; ns[0] = hre; ns[2048] = him; }
        }
    }
    GRID_SYNC_N(4);
    { GSC g{(const char*)UH, (const char*)MEM, ZB}; gemm_phase(lds, g, 0, 96); }
    if (blockIdx.x >= 96) {
        FRESH_IDS
        LAS float* scr = (LAS float*)(lds + 32768 + wave * 8704);
        const int nw = (gridDim.x - 96) * 8;
        for (int it = (blockIdx.x - 96) * 8 + wave; it < 4736; it += nw) {
            int r = it;
            if (r < 512) { const int kb = r / 32, nb = r % 32; transpose_item(w_o, 1024, 32 * nb, 64 * kb, WO, 32 * nb, 1024, scr, lane); continue; } r -= 512;
            if (r < 1408) { const int kb = r / 88, nb = r % 88, n0 = 32 * nb; transpose_item(w_g, 2816, n0, 64 * kb, WGU, 256 * (n0 >> 7) + (n0 & 127), 1024, scr, lane); continue; } r -= 1408;
            if (r < 1408) { const int kb = r / 88, nb = r % 88, n0 = 32 * nb; transpose_item(w_u, 2816, n0, 64 * kb, WGU, 256 * (n0 >> 7) + 128 + (n0 & 127), 1024, scr, lane); continue; } r -= 1408;
            { const int kb = r / 32, nb = r % 32; transpose_item_fp8(w_d, 1024, 32 * nb, 64 * kb, (unsigned char*)WD, 32 * nb, 2816, 32.0f, scr, lane); }
        }
    }
    GRID_SYNC_N(5);
    }
    {
    { Gglu g{(const char*)ZB, (const char*)WGLU, b_glu, YS, (unsigned*)(ws + WS_CNT)}; gemm_phase(lds, g, 0, 128); }
    if (blockIdx.x >= 128) {
        FRESH_IDS
        const int nw = (gridDim.x - 128) * 8;
        for (int n = (blockIdx.x - 128) * 8 + wave; n < 5632; n += nw) {
            const u32x4 w0 = *(const u32x4*)(WGU + (size_t)n * 1024 + 16 * lane), w1 = *(const u32x4*)(WGU + (size_t)n * 1024 + 16 * lane + 8);
            f32x4 wa, wb, wc4, wd; unpack8(w0, wa, wb); unpack8(w1, wc4, wd);
            float dsum[3];
#pragma unroll
            for (int mi = 0; mi < 3; ++mi) { const float* sh = MOD + mi * 6144 + 3 * 1024 + 16 * lane;
                const f32x4 s0 = *(const f32x4*)(sh), s1 = *(const f32x4*)(sh + 4), s2 = *(const f32x4*)(sh + 8), s3 = *(const f32x4*)(sh + 12);
                const f32x4 p = wa * s0 + wb * s1 + wc4 * s2 + wd * s3; dsum[mi] = (p[0] + p[1]) + (p[2] + p[3]); }
#pragma unroll
            for (int o = 1; o < 64; o <<= 1) { dsum[0] += __shfl_xor(dsum[0], o); dsum[1] += __shfl_xor(dsum[1], o); dsum[2] += __shfl_xor(dsum[2], o); }
            if (lane < 3) st4f(SVGU + lane * 5632 + n, lane == 0 ? dsum[0] : (lane == 1 ? dsum[1] : dsum[2]));
        }
    }
    { Gproj g{(const char*)YS, (const char*)YF, (const char*)WPS, (const char*)WPF, SG, MB, (unsigned*)(ws + WS_CNT)}; gemm_phase(lds, g, 0, 256); }
    GRID_SYNC_N(7);
    { Gwo g{(const char*)MB, (const char*)WO, x_prompt, x_sample, MOD, norm2_g, X1, A2B, SSQ2}; gemm_phase(lds, g, 0, 256); }
    GRID_SYNC_N(8);
    }
    {
    { Ggu g{(const char*)A2B, (const char*)WGU, SSQ2, SVGU, FF, (unsigned*)(ws + WS_CNT)}; gemm_phase(lds, g, 0, 1408);
#if REP_P6 > 1
      gemm_phase(lds, g, 0, 1408);
#endif
    }
    }
    {
    { Gdn g{(const char*)FF, (const char*)WD, X1, MOD, OUT, SSQ3, fin_g, (unsigned*)(ws + WS_CNT)}; gemm_phase(lds, g, 0, 256);
#if REP_P7 > 1
      gemm_phase(lds, g, 0, 192);
#endif
    }
    }
}

#undef ws
#undef OUT
constexpr int LDS_BYTES = 8 * HTB + 16384;

extern "C" void kernel_launch(void* const* d_in, const int* in_sizes, int n_in, void* d_out, int out_size, void* d_ws, size_t ws_size, hipStream_t stream) {
    static int grid = 0;
    if (grid == 0) {
        int dev = 0, cus = 0, per_cu = 0;
        hipGetDevice(&dev);
        hipDeviceGetAttribute(&cus, hipDeviceAttributeMultiprocessorCount, dev);
        if (hipFuncSetAttribute((const void*)fwd_kernel, hipFuncAttributeMaxDynamicSharedMemorySize, LDS_BYTES) != hipSuccess) fprintf(stderr, "hipFuncSetAttribute failed\n");
        if (hipOccupancyMaxActiveBlocksPerMultiprocessor(&per_cu, (const void*)fwd_kernel, 512, LDS_BYTES) != hipSuccess || per_cu < 1) { fprintf(stderr, "occupancy query: %d\n", per_cu); per_cu = 1; }
        (void)hipGetLastError();
        grid = cus > 0 ? cus : 256;
        if (ws_size < WS_END) fprintf(stderr, "workspace too small: %zu < %zu\n", ws_size, (size_t)WS_END);
    }
    (void)hipMemsetAsync((char*)d_ws + WS_BAR, 0, 32768, stream);
    Params p{};
    for (int i = 0; i < 27; ++i) p.in[i] = (const float*)d_in[i];
    p.out = (float*)d_out; p.wsp = (unsigned char*)d_ws;
    void* args[] = {&p};
    hipError_t e = hipLaunchCooperativeKernel((const void*)fwd_kernel, dim3(grid), dim3(512), args, LDS_BYTES, stream);
    if (e != hipSuccess) fprintf(stderr, "cooperative launch failed: %s (grid %d)\n", hipGetErrorString(e), grid);
}
```
